# Optimizing an MI355X kernel written in HIP

```python
import math
import jax, jax.numpy as jnp
from jax import lax
import numpy as np

D_MODEL = 1024
BATCH = 4
SEQ = 4096
DEPTH = 1

CTX_LEN = 256
GRID_W = 64
CHUNK = 128
RET_HEADS = 4
RET_QK_DIM = 128
RET_V_DIM = 128
RET_WIDTH = RET_HEADS * RET_V_DIM
GMLP_GROUPS = 4
GMLP_GROUP_DIM = 128
GMLP_WIDTH = GMLP_GROUPS * GMLP_GROUP_DIM
MIX_WIDTH = RET_WIDTH + GMLP_WIDTH
IN_COLS = 4 * RET_WIDTH + 2 * GMLP_WIDTH
D_FF = 2816
N_MOD = 9
ROPE_BASE = 10000.0
EPS = 1e-6

kernel_name = "hybrid_retention_gmlp_macaron_dit"


def rmsnorm(x, g):
    xf = x.astype(jnp.float32)
    y = xf * lax.rsqrt(jnp.mean(xf * xf, axis=-1, keepdims=True) + EPS)
    return (y * g.astype(jnp.float32)).astype(x.dtype)


def modulate(h, shift, scale):
    return h * (1 + scale) + shift


def swiglu(h, w1, w2):
    gate, up = jnp.split(h @ w1, 2, axis=-1)
    return (jax.nn.silu(gate) * up) @ w2


def to_heads(t, n_heads):
    b, n, _ = t.shape
    return t.reshape(b, n, n_heads, -1).transpose(0, 2, 1, 3)


def rope_2d(t, row, col):
    half = t.shape[-1] // 2
    n_freq = half // 2
    freqs = ROPE_BASE ** (-jnp.arange(n_freq, dtype=jnp.float32) / n_freq)
    ang = jnp.concatenate([row[:, None] * freqs, col[:, None] * freqs], axis=-1)
    cos, sin = jnp.cos(ang), jnp.sin(ang)
    t1, t2 = t[..., :half], t[..., half:]
    return jnp.concatenate([t1 * cos - t2 * sin, t1 * sin + t2 * cos], axis=-1)


def retention_scan(q, k, v, log_gamma, s0):
    b, h, n, dk = q.shape
    dv = v.shape[-1]
    nc = n // CHUNK
    idx = jnp.arange(CHUNK, dtype=jnp.float32)
    diff = idx[:, None] - idx[None, :]
    lower = diff >= 0
    dmask = jnp.where(lower[None], jnp.exp(jnp.where(lower, diff, 0.0)[None] * log_gamma[:, None, None]), 0.0)
    xi = jnp.exp((idx + 1.0)[None] * log_gamma[:, None])
    zeta = jnp.exp((CHUNK - 1.0 - idx)[None] * log_gamma[:, None])
    chunk_decay = jnp.exp(CHUNK * log_gamma)

    def to_chunks(t):
        return t.reshape(b, h, nc, CHUNK, -1).transpose(2, 0, 1, 3, 4)

    def step(s, qkv):
        qc, kc, vc = qkv
        scores = jnp.einsum('bhid,bhjd->bhij', qc, kc) * dmask
        o = (jnp.einsum('bhij,bhjv->bhiv', scores, vc)
             + jnp.einsum('bhid,bhdv->bhiv', qc * xi[:, :, None], s))
        s_new = chunk_decay[:, None, None] * s + jnp.einsum('bhjd,bhjv->bhdv', kc * zeta[:, :, None], vc)
        return s_new, o

    s_fin, o = lax.scan(step, s0, (to_chunks(q), to_chunks(k), to_chunks(v)))
    o = o.transpose(1, 2, 0, 3, 4).reshape(b, h, n, dv)
    return o, s_fin


def bidir_retention(q, k, v, lg_fwd, lg_bwd, s0_fwd, s0_bwd):
    flip = lambda t: t[:, :, ::-1]
    o_f, s_f = retention_scan(q, k, v, lg_fwd, s0_fwd)
    o_b, s_b = retention_scan(flip(q), flip(k), flip(v), lg_bwd, s0_bwd)
    return o_f + flip(o_b), s_f, s_b


def retention_readout(y, gate):
    y = y * lax.rsqrt(jnp.mean(y * y, axis=-1, keepdims=True) + EPS)
    b, h, n, dv = y.shape
    y = y.transpose(0, 2, 1, 3).reshape(b, n, h * dv).astype(gate.dtype)
    return y * jax.nn.silu(gate)


def chunk_gmlp(u, v, w_s, b_s):
    b, n, _ = u.shape
    nc = n // CHUNK
    vg = v.reshape(b, nc, CHUNK, GMLP_GROUPS, GMLP_GROUP_DIM).astype(jnp.float32)
    mu = jnp.mean(vg, axis=-1, keepdims=True)
    var = jnp.mean(jnp.square(vg - mu), axis=-1, keepdims=True)
    vn = ((vg - mu) * lax.rsqrt(var + EPS)).astype(u.dtype)
    mixed = jnp.einsum('gpq,bcqgd->bcpgd', w_s, vn) + b_s.T[None, None, :, :, None]
    ug = u.reshape(b, nc, CHUNK, GMLP_GROUPS, GMLP_GROUP_DIM)
    return (ug * mixed).reshape(b, n, GMLP_WIDTH)


def split_proj(p):
    r, g = RET_WIDTH, GMLP_WIDTH
    return jnp.split(p, [r, 2 * r, 3 * r, 4 * r, 4 * r + g], axis=-1)


def setup_inputs(seed: int = 0) -> dict:
    key = jax.random.key(seed)
    ks = jax.random.split(key, 20)
    f32 = jnp.float32
    nrm = lambda k, s, sc: jax.random.normal(k, s, f32) * sc
    base_rate = np.log(-np.log(1.0 - 2.0 ** (-5.0 - np.arange(RET_HEADS)))).astype(np.float32)
    ret_decay = jnp.asarray(base_rate)[None, None, :] + nrm(ks[12], (DEPTH, 2, RET_HEADS), 0.05)
    return {
        "x": nrm(ks[0], (BATCH, SEQ, D_MODEL), 1.0),
        "c": nrm(ks[1], (BATCH, D_MODEL), 1.0),
        "ctx": nrm(ks[2], (BATCH, CTX_LEN, D_MODEL), 1.0),
        "c_ctx": nrm(ks[3], (D_MODEL,), 1.0),
        "w_ada": nrm(ks[4], (DEPTH, D_MODEL, N_MOD * D_MODEL), 0.02),
        "b_ada": nrm(ks[5], (DEPTH, N_MOD * D_MODEL), 0.02),
        "norm_g": 1.0 + nrm(ks[6], (DEPTH, 3, D_MODEL), 0.02),
        "ffn1_w1": nrm(ks[7], (DEPTH, D_MODEL, 2 * D_FF), D_MODEL ** -0.5),
        "ffn1_w2": nrm(ks[8], (DEPTH, D_FF, D_MODEL), D_FF ** -0.5),
        "w_in": nrm(ks[9], (DEPTH, D_MODEL, IN_COLS), D_MODEL ** -0.5),
        "ret_decay": ret_decay,
        "gmlp_ws": nrm(ks[10], (DEPTH, GMLP_GROUPS, CHUNK, CHUNK), 0.5 * CHUNK ** -0.5),
        "gmlp_bs": 1.0 + nrm(ks[11], (DEPTH, GMLP_GROUPS, CHUNK), 0.02),
        "w_out": nrm(ks[13], (DEPTH, MIX_WIDTH, D_MODEL), MIX_WIDTH ** -0.5),
        "ffn2_w1": nrm(ks[14], (DEPTH, D_MODEL, 2 * D_FF), D_MODEL ** -0.5),
        "ffn2_w2": nrm(ks[15], (DEPTH, D_FF, D_MODEL), D_FF ** -0.5),
        "final_g": 1.0 + nrm(ks[16], (D_MODEL,), 0.02),
    }


def reference(x, c, ctx, c_ctx, w_ada, b_ada, norm_g, ffn1_w1, ffn1_w2, w_in, ret_decay,
              gmlp_ws, gmlp_bs, w_out, ffn2_w1, ffn2_w2, final_g):
    b, n, _ = x.shape
    rows = n // GRID_W
    row = jnp.repeat(jnp.arange(rows, dtype=jnp.float32), GRID_W)
    col = jnp.tile(jnp.arange(GRID_W, dtype=jnp.float32), rows)
    k_scale = RET_QK_DIM ** -0.5

    for l in range(DEPTH):
        last = l == DEPTH - 1
        m_x = [t[:, None, :] for t in jnp.split(jax.nn.silu(c) @ w_ada[l] + b_ada[l], N_MOD, axis=-1)]
        m_c = [t[None, None, :] for t in jnp.split(jax.nn.silu(c_ctx) @ w_ada[l] + b_ada[l], N_MOD, axis=-1)]

        x = x + 0.5 * m_x[2] * swiglu(modulate(rmsnorm(x, norm_g[l, 0]), m_x[0], m_x[1]), ffn1_w1[l], ffn1_w2[l])
        ctx = ctx + 0.5 * m_c[2] * swiglu(modulate(rmsnorm(ctx, norm_g[l, 0]), m_c[0], m_c[1]), ffn1_w1[l], ffn1_w2[l])

        px = modulate(rmsnorm(x, norm_g[l, 1]), m_x[3], m_x[4]) @ w_in[l]
        pc = modulate(rmsnorm(ctx, norm_g[l, 1]), m_c[3], m_c[4]) @ w_in[l]
        qx, kx, vx, gx, ux, vgx = split_proj(px)
        qc, kc, vc, gc, uc, vgc = split_proj(pc)

        lg_fwd = -jnp.exp(ret_decay[l, 0].astype(jnp.float32))
        lg_bwd = -jnp.exp(ret_decay[l, 1].astype(jnp.float32))

        qch = to_heads(qc, RET_HEADS).astype(jnp.float32)
        kch = to_heads(kc, RET_HEADS).astype(jnp.float32) * k_scale
        vch = to_heads(vc, RET_HEADS).astype(jnp.float32)
        s_zero = jnp.zeros((b, RET_HEADS, RET_QK_DIM, RET_V_DIM), jnp.float32)
        yc, s_fwd_c, s_bwd_c = bidir_retention(qch, kch, vch, lg_fwd, lg_bwd, s_zero, s_zero)

        qxh = rope_2d(to_heads(qx, RET_HEADS).astype(jnp.float32), row, col)
        kxh = rope_2d(to_heads(kx, RET_HEADS).astype(jnp.float32), row, col) * k_scale
        vxh = to_heads(vx, RET_HEADS).astype(jnp.float32)
        yx, _, _ = bidir_retention(qxh, kxh, vxh, lg_fwd, lg_bwd, s_fwd_c, s_bwd_c)
        ret_x = retention_readout(yx, gx)

        gm_x = chunk_gmlp(jax.nn.gelu(ux), jax.nn.gelu(vgx), gmlp_ws[l], gmlp_bs[l])

        x = x + m_x[5] * (jnp.concatenate([ret_x, gm_x], axis=-1) @ w_out[l])
        if not last:
            ret_c = retention_readout(yc, gc)
            gm_c = chunk_gmlp(jax.nn.gelu(uc), jax.nn.gelu(vgc), gmlp_ws[l], gmlp_bs[l])
            ctx = ctx + m_c[5] * (jnp.concatenate([ret_c, gm_c], axis=-1) @ w_out[l])

        x = x + 0.5 * m_x[8] * swiglu(modulate(rmsnorm(x, norm_g[l, 2]), m_x[6], m_x[7]), ffn2_w1[l], ffn2_w2[l])
        if not last:
            ctx = ctx + 0.5 * m_c[8] * swiglu(modulate(rmsnorm(ctx, norm_g[l, 2]), m_c[6], m_c[7]), ffn2_w1[l], ffn2_w2[l])

    return rmsnorm(x, final_g)
```

```cpp
#include <hip/hip_runtime.h>
#include <hip/hip_cooperative_groups.h>
#include <cstdio>
#include <cstdint>
namespace cg = cooperative_groups;
__device__ __forceinline__ int ltid() { int t = threadIdx.x; asm volatile("" : "+v"(t)); return t; }
__device__ __forceinline__ int lbid() { int t = blockIdx.x; asm volatile("" : "+s"(t)); return t; }
typedef float f32x2_t __attribute__((ext_vector_type(2))); typedef __bf16 bf16x2_t __attribute__((ext_vector_type(2)));
__device__ __forceinline__ unsigned cvtpk(float lo, float hi) { f32x2_t v = {lo, hi}; bf16x2_t b = __builtin_convertvector(v, bf16x2_t); return __builtin_bit_cast(unsigned, b); }
namespace pg8 {
#define PG8_LAS __attribute__((address_space(3)))
typedef unsigned short bf16_t;
typedef short bf16x8 __attribute__((ext_vector_type(8)));
typedef float f32x4 __attribute__((ext_vector_type(4)));
typedef unsigned u32x4 __attribute__((ext_vector_type(4)));
constexpr int BM = 256, BK = 64, HALF = 128, HTB = HALF * BK * 2  , STAGE_BYTES = 8 * HTB, NXCD = 8, WGM = 8;

__host__ __device__ __forceinline__ int lds_byte(int r, int c) { const int st = (r >> 4) * 2 + (c >> 5), rr = r & 15, cc = c & 31, ob = rr * 64 + cc * 2; return st * 1024 + (ob ^ (((ob >> 9) & 1) << 5)); }
__host__ __device__ __forceinline__ void stage_rc(int b, int& R, int& C) { const int st = b / 1024, sb = b % 1024, swz = sb ^ (((sb >> 9) & 1) << 5); R = (st >> 1) * 16 + swz / 64; C = (st & 1) * 32 + (swz % 64) / 2; }
__host__ __device__ __forceinline__ int perm32(int rho) { const int n = rho >> 4, i = rho & 15; return 8 * (i >> 2) + 4 * n + (i & 3); }

struct Unit { int pm, pn; };
struct Gemm { const bf16_t* A; const bf16_t* Bt; int M, N, K; };

struct StaticOrder {
    int nM, nN, nwg, G, c;
    __host__ __device__ void init(int M, int N, int G_, int c_) { nM = M / BM; nN = N / BM; nwg = nM * nN; G = G_; c = c_; }
    __host__ __device__ bool next(int i, Unit& u) const {
        const long L = (long)i * G + c; if (L >= nwg) return false;
        int wgid = (int)L; { const int q = nwg / NXCD, r = nwg % NXCD, xcd = wgid % NXCD, off = wgid / NXCD; wgid = (xcd < r ? xcd * (q + 1) : r * (q + 1) + (xcd - r) * q) + off; }
        const int nig = WGM * nN, gid = wgid / nig, fm = gid * WGM, gsz = (nM - fm) < WGM ? (nM - fm) : WGM;
        u.pm = fm + ((wgid % nig) % gsz); u.pn = (wgid % nig) / gsz; return true;
    }
    __device__ __forceinline__ void a_ready(const Unit&) const {}
    __device__ __forceinline__ void done(const Unit&) const {}
};

__device__ __forceinline__ unsigned cvt_pk_bf16(float lo, float hi) { unsigned r; asm volatile("v_cvt_pk_bf16_f32 %0, %1, %2" : "=v"(r) : "v"(lo), "v"(hi)); return r; }
typedef float f32x2 __attribute__((ext_vector_type(2)));

__device__ __forceinline__ float silu_f(float x) { return x * __builtin_amdgcn_rcpf(1.0f + __expf(-x)); }

struct EpiSwiglu {
    static constexpr bool PERM = true, AFTER_DRAIN = false;
    bf16_t* O; int ldc;
    __device__ __forceinline__ void operator()(const f32x4 (&acc)[2][2][4][2], const Unit& u, int wr, int wc, int fr, int fq) const {
        const int row0 = u.pm * BM + wr * 64 + fr, col0 = u.pn * HALF + wc * 32 + 8 * fq;
#pragma unroll
        for (int ai = 0; ai < 2; ++ai)
#pragma unroll
            for (int m = 0; m < 4; ++m) {
                bf16_t* rowp = O + (size_t)(row0 + ai * HALF + m * 16) * ldc + col0;
                const f32x4 g0 = acc[ai][0][m][0], g1 = acc[ai][0][m][1], u0 = acc[ai][1][m][0], u1 = acc[ai][1][m][1];
                u32x4 w;
                w.x = ::cvtpk(silu_f(g0[0]) * u0[0], silu_f(g0[1]) * u0[1]); w.y = ::cvtpk(silu_f(g0[2]) * u0[2], silu_f(g0[3]) * u0[3]);
                w.z = ::cvtpk(silu_f(g1[0]) * u1[0], silu_f(g1[1]) * u1[1]); w.w = ::cvtpk(silu_f(g1[2]) * u1[2], silu_f(g1[3]) * u1[3]);
                *(u32x4*)rowp = w;
            }
    }
};
struct EpiPlainBf16 {
    static constexpr bool PERM = true, AFTER_DRAIN = false;
    bf16_t* O; int ldc;
    __device__ __forceinline__ void operator()(const f32x4 (&acc)[2][2][4][2], const Unit& u, int wr, int wc, int fr, int fq) const {
        const int row0 = u.pm * BM + wr * 64 + fr, col0 = u.pn * BM + wc * 32 + 8 * fq;
#pragma unroll
        for (int ai = 0; ai < 2; ++ai)
#pragma unroll
            for (int m = 0; m < 4; ++m) {
                bf16_t* rowp = O + (size_t)(row0 + ai * HALF + m * 16) * ldc + col0;
#pragma unroll
                for (int bj = 0; bj < 2; ++bj) {
                    const f32x4 v0 = acc[ai][bj][m][0], v1 = acc[ai][bj][m][1];
                    u32x4 w; w.x = ::cvtpk(v0[0], v0[1]); w.y = ::cvtpk(v0[2], v0[3]); w.z = ::cvtpk(v1[0], v1[1]); w.w = ::cvtpk(v1[2], v1[3]);
                    *(u32x4*)(rowp + bj * HALF) = w;
                }
            }
    }
};
struct EpiResid {
    static constexpr bool PERM = false, AFTER_DRAIN = false;
    const float* xin_lat; const float* xin_ctx; float* out_lat; float* out_ctx; const float* mod; int slot; float coef;
    __device__ __forceinline__ void operator()(const f32x4 (&acc)[2][2][4][2], const Unit& u, int wr, int wc, int fr, int fq) const {
        const bool isctx = u.pm >= 64; const int mb = isctx ? 4 : (u.pm >> 4);
        const float* xin = isctx ? xin_ctx : xin_lat; float* out = isctx ? out_ctx : out_lat;
        const int row0 = (isctx ? u.pm - 64 : u.pm) * BM + wr * 64 + fr, col0 = u.pn * BM + wc * 32 + 4 * fq;
        const float* mrow = mod + mb * 9216 + slot * 1024 + col0;
        f32x4 gv[2][2];
#pragma unroll
        for (int bj = 0; bj < 2; ++bj)
#pragma unroll
            for (int n = 0; n < 2; ++n) gv[bj][n] = *(const f32x4*)(mrow + bj * HALF + n * 16) * coef;
#pragma unroll
        for (int ai = 0; ai < 2; ++ai)
#pragma unroll
            for (int m = 0; m < 4; ++m) { const size_t off = (size_t)(row0 + ai * HALF + m * 16) * 1024 + col0;
#pragma unroll
                for (int bj = 0; bj < 2; ++bj)
#pragma unroll
                    for (int n = 0; n < 2; ++n) { const f32x4 xi = *(const f32x4*)(xin + off + bj * HALF + n * 16);
                        *(f32x4*)(out + off + bj * HALF + n * 16) = xi + gv[bj][n] * acc[ai][bj][m][n]; } }
    }
};

template <class Epi, class Sched, bool ALIGN_EPI = false, bool SP2 = false>
__device__ __forceinline__ void gemm_phase(PG8_LAS unsigned char* lds, const Gemm g, const Sched& S, const Epi& E) {
    const int tid = ltid(), wid = __builtin_amdgcn_readfirstlane(tid >> 6), lane = tid & 63, wr = wid >> 2, wc = wid & 3, fr = lane & 15, fq = lane >> 4;
    const int K = g.K, nt = K / BK;
    unsigned voffA[2], voffB[2];
#pragma unroll
    for (int i = 0; i < 2; ++i) { int R, C; stage_rc(tid * 16 + i * 8192, R, C); const int Rb = Epi::PERM ? ((R & ~31) + perm32(R & 31)) : R;
        voffA[i] = (unsigned)(R * K + C) * 2u; voffB[i] = (unsigned)(Rb * K + C) * 2u; }
    const size_t kstep = (size_t)(BK * 2);
    const size_t hstep = (size_t)HALF * K * 2;
    const size_t tstep = 2 * hstep;
    const unsigned ldsw = (unsigned)wid * 1024u;
    const int aoff = lds_byte(wr * 64 + fr, fq * 8), boff = lds_byte(wc * 32 + fr, fq * 8);
#define PG8_SA(b, h) (((b) * 2 + (h)) * HTB)
#define PG8_SB(b, h) ((4 + (b) * 2 + (h)) * HTB)
#define PG8_STAGE(bufoff, gbase, voff) do { _Pragma("unroll") for (int _i = 0; _i < 2; ++_i) \
        __builtin_amdgcn_global_load_lds((const unsigned*)((const char*)(gbase) + (voff)[_i]), (PG8_LAS unsigned*)(lds + (bufoff) + ldsw + _i * 8192), 16, 0, 0); } while (0)
#define PG8_LDA(dst, b, h) do { _Pragma("unroll") for (int m = 0; m < 4; ++m) _Pragma("unroll") for (int k = 0; k < 2; ++k) dst[m][k] = *(const PG8_LAS bf16x8*)(lds + PG8_SA(b, h) + aoff + m * 2048 + k * 1024); } while (0)
#define PG8_LDB(dst, b, h) do { _Pragma("unroll") for (int n = 0; n < 2; ++n) _Pragma("unroll") for (int k = 0; k < 2; ++k) dst[n][k] = *(const PG8_LAS bf16x8*)(lds + PG8_SB(b, h) + boff + n * 2048 + k * 1024); } while (0)
#define PG8_MMA(ai, bj, At, Bt) do { __builtin_amdgcn_s_setprio(1); _Pragma("unroll") for (int m = 0; m < 4; ++m) _Pragma("unroll") for (int n = 0; n < 2; ++n) _Pragma("unroll") for (int k = 0; k < 2; ++k) \
        acc[ai][bj][m][n] = __builtin_amdgcn_mfma_f32_16x16x32_bf16(Bt[n][k], At[m][k], acc[ai][bj][m][n], 0, 0, 0); __builtin_amdgcn_s_setprio(0); } while (0)
#define PG8_WAIT_V(n) asm volatile("s_waitcnt vmcnt(" #n ")" ::: "memory")
#define PG8_WAIT_L(n) asm volatile("s_waitcnt lgkmcnt(" #n ")" ::: "memory")
#define PG8_BAR __builtin_amdgcn_s_barrier()
#define PG8_SCHED __builtin_amdgcn_sched_barrier(0)
    Unit cur, nxt; int ui = 0;
    if (!S.next(0, cur)) return;
    f32x4 acc[2][2][4][2];
#pragma unroll
    for (int a = 0; a < 2; ++a)
#pragma unroll
        for (int b = 0; b < 2; ++b)
#pragma unroll
            for (int m = 0; m < 4; ++m)
#pragma unroll
                for (int n = 0; n < 2; ++n) acc[a][b][m][n] = (f32x4){0.f, 0.f, 0.f, 0.f};
    bf16x8 At[4][2], B0[2][2], B1[2][2];
    const char* cA = (const char*)g.A + (size_t)cur.pm * tstep; const char* cB = (const char*)g.Bt + (size_t)cur.pn * tstep;
    S.a_ready(cur);
    if constexpr (SP2) {
        PG8_STAGE(PG8_SB(0, 0), cB, voffB); PG8_STAGE(PG8_SB(0, 1), cB + hstep, voffB); PG8_STAGE(PG8_SA(0, 0), cA, voffA); PG8_STAGE(PG8_SA(0, 1), cA + hstep, voffA);
        if (wr == 1) PG8_BAR;
        PG8_WAIT_V(2); PG8_BAR;
        PG8_STAGE(PG8_SB(1, 0), cB + kstep, voffB); PG8_STAGE(PG8_SA(1, 0), cA + kstep, voffA); PG8_STAGE(PG8_SB(1, 1), cB + hstep + kstep, voffB);
        PG8_WAIT_V(6); PG8_BAR;
    } else {
        PG8_STAGE(PG8_SB(0, 0), cB, voffB); PG8_STAGE(PG8_SA(0, 0), cA, voffA); PG8_STAGE(PG8_SB(0, 1), cB + hstep, voffB); PG8_STAGE(PG8_SA(0, 1), cA + hstep, voffA);
        if (wr == 1) PG8_BAR;
        PG8_WAIT_V(4); PG8_BAR;
        PG8_STAGE(PG8_SB(1, 0), cB + kstep, voffB); PG8_STAGE(PG8_SA(1, 0), cA + kstep, voffA); PG8_STAGE(PG8_SB(1, 1), cB + hstep + kstep, voffB);
        PG8_WAIT_V(6); PG8_BAR;
    }
    for (;;) {
        const bool has_next = S.next(ui + 1, nxt);
        const char* nA = has_next ? (const char*)g.A + (size_t)nxt.pm * tstep : cA; const char* nB = has_next ? (const char*)g.Bt + (size_t)nxt.pn * tstep : cB;
        for (int t = 0; t < nt; t += 2) {
            const bool last = (t == nt - 2);
            const char* a1 = cA + (size_t)(t + 1) * kstep;
            const char* a2 = last ? nA : cA + (size_t)(t + 2) * kstep; const char* b2 = last ? nB : cB + (size_t)(t + 2) * kstep;
            const char* a3 = a2 + kstep; const char* b3 = b2 + kstep;
            if (last && has_next) S.a_ready(nxt);
            if constexpr (SP2) {
            PG8_LDB(B0, 0, 0); PG8_LDB(B1, 0, 1); PG8_SCHED; PG8_LDA(At, 0, 0); PG8_STAGE(PG8_SA(1, 1), a1 + hstep, voffA);
            PG8_WAIT_V(8); PG8_WAIT_L(0); PG8_BAR; PG8_MMA(0, 0, At, B0); PG8_MMA(0, 1, At, B1); PG8_BAR; PG8_SCHED;
            PG8_LDA(At, 0, 1); PG8_STAGE(PG8_SB(0, 0), b2, voffB); PG8_STAGE(PG8_SB(0, 1), b2 + hstep, voffB); PG8_STAGE(PG8_SA(0, 0), a2, voffA);
            PG8_WAIT_V(8); PG8_WAIT_L(0); PG8_BAR; PG8_MMA(1, 0, At, B0); PG8_MMA(1, 1, At, B1); PG8_BAR; PG8_SCHED;
            PG8_LDB(B0, 1, 0); PG8_LDB(B1, 1, 1); PG8_SCHED; PG8_LDA(At, 1, 0); PG8_STAGE(PG8_SA(0, 1), a2 + hstep, voffA);
            PG8_WAIT_V(8); PG8_WAIT_L(0); PG8_BAR; PG8_MMA(0, 0, At, B0); PG8_MMA(0, 1, At, B1); PG8_BAR; PG8_SCHED;
            PG8_LDA(At, 1, 1); PG8_STAGE(PG8_SB(1, 0), b3, voffB); PG8_STAGE(PG8_SB(1, 1), b3 + hstep, voffB); PG8_STAGE(PG8_SA(1, 0), a3, voffA);
            PG8_WAIT_V(8); PG8_WAIT_L(0); PG8_BAR; PG8_MMA(1, 0, At, B0); PG8_MMA(1, 1, At, B1); PG8_BAR; PG8_SCHED;
            } else {
            PG8_LDB(B0, 0, 0); PG8_SCHED; PG8_LDA(At, 0, 0); PG8_STAGE(PG8_SA(1, 1), a1 + hstep, voffA);
            PG8_WAIT_L(8); PG8_BAR; PG8_WAIT_L(0); PG8_MMA(0, 0, At, B0); PG8_BAR; PG8_SCHED;
            PG8_LDB(B1, 0, 1); PG8_STAGE(PG8_SB(0, 0), b2, voffB);
            PG8_BAR; PG8_WAIT_L(0); PG8_MMA(0, 1, At, B1); PG8_BAR;
            PG8_LDA(At, 0, 1); PG8_STAGE(PG8_SA(0, 0), a2, voffA);
            PG8_BAR; PG8_WAIT_L(0); PG8_MMA(1, 0, At, B0); PG8_BAR; PG8_SCHED;
            PG8_STAGE(PG8_SB(0, 1), b2 + hstep, voffB);
            PG8_WAIT_V(6); PG8_BAR; PG8_MMA(1, 1, At, B1); PG8_BAR;
            PG8_LDB(B0, 1, 0); PG8_SCHED; PG8_LDA(At, 1, 0); PG8_STAGE(PG8_SA(0, 1), a2 + hstep, voffA);
            PG8_WAIT_L(8); PG8_BAR; PG8_WAIT_L(0); PG8_MMA(0, 0, At, B0); PG8_BAR; PG8_SCHED;
            PG8_LDB(B1, 1, 1); PG8_STAGE(PG8_SB(1, 0), b3, voffB);
            PG8_BAR; PG8_WAIT_L(0); PG8_MMA(0, 1, At, B1); PG8_BAR;
            PG8_LDA(At, 1, 1); PG8_STAGE(PG8_SA(1, 0), a3, voffA);
            PG8_BAR; PG8_WAIT_L(0); PG8_MMA(1, 0, At, B0); PG8_BAR; PG8_SCHED;
            PG8_STAGE(PG8_SB(1, 1), b3 + hstep, voffB);
            PG8_WAIT_V(6); PG8_BAR; PG8_MMA(1, 1, At, B1); PG8_BAR;
            }
        }
        if constexpr (ALIGN_EPI) { if (wr == 0) PG8_BAR; }
        if constexpr (!Epi::AFTER_DRAIN) { E(acc, cur, wr, wc, fr, fq); S.done(cur); }
        if (!has_next) break;
#pragma unroll
        for (int a = 0; a < 2; ++a)
#pragma unroll
            for (int b = 0; b < 2; ++b)
#pragma unroll
                for (int m = 0; m < 4; ++m)
#pragma unroll
                    for (int n = 0; n < 2; ++n) acc[a][b][m][n] = (f32x4){0.f, 0.f, 0.f, 0.f};
        cur = nxt; cA = nA; cB = nB; ++ui;
        if constexpr (ALIGN_EPI) { if (wr == 1) PG8_BAR; }
    }
    PG8_WAIT_V(0);
    if constexpr (!ALIGN_EPI) { if (wr == 0) PG8_BAR; }
    PG8_BAR;
    if constexpr (Epi::AFTER_DRAIN) { E.fused(acc, cur, wr, wc, fr, fq, lds, wid, lane); S.done(cur); }
#undef PG8_SA
#undef PG8_SB
#undef PG8_STAGE
#undef PG8_LDA
#undef PG8_LDB
#undef PG8_MMA
#undef PG8_WAIT_V
#undef PG8_WAIT_L
#undef PG8_BAR
#undef PG8_SCHED
}
}

#define LAS __attribute__((address_space(3)))
typedef unsigned short bf16;
typedef float f32x4 __attribute__((ext_vector_type(4)));
typedef short bf16x8 __attribute__((ext_vector_type(8)));
typedef unsigned u32x4 __attribute__((ext_vector_type(4)));
typedef unsigned u32x2 __attribute__((ext_vector_type(2)));

constexpr int D = 1024, NB = 4, SEQ = 4096, CTXL = 256, MX = NB * SEQ, MC = NB * CTXL, MT = MX + MC;
constexpr int FF = 2816, NIN = 3072, NMODC = 9 * D;
constexpr int CH = 128, NCH = SEQ / CH, NHEAD = 4;
constexpr float EPS = 1e-6f;
constexpr int NTHR = 512, NWAVES = 8;
constexpr int LDS_BYTES = 147456;
constexpr int TP = 136;
constexpr int TILE_B = 128 * TP * 2;
static_assert(4 * TILE_B <= LDS_BYTES, "lds");

constexpr size_t MiB = 1u << 20;
constexpr size_t WS_MOD = 0;
constexpr size_t WS_W1A = 1 * MiB, WS_W2A = 12 * MiB, WS_WIN = 18 * MiB, WS_WOUT = 24 * MiB, WS_W1B = 26 * MiB, WS_W2B = 37 * MiB;
constexpr size_t WS_X1C = 43 * MiB;
constexpr size_t WS_H = 47 * MiB;
constexpr size_t WS_MIX = 81 * MiB;
constexpr size_t WS_ACT = 113 * MiB;
constexpr size_t WS_END = 215 * MiB;

struct Args { const float* in[17]; float* out; unsigned char* ws; int ph_lo, ph_hi; };

__device__ __forceinline__ unsigned pk2(float lo, float hi) { return cvtpk(lo, hi); }
__device__ __forceinline__ float bf_lo(unsigned w) { return __uint_as_float(w << 16); }
__device__ __forceinline__ float bf_hi(unsigned w) { return __uint_as_float(w & 0xffff0000u); }
__device__ __forceinline__ float wave_sum(float v) {
#pragma unroll
    for (int o = 1; o < 64; o <<= 1) v += __shfl_xor(v, o);
    return v;
}
__device__ __forceinline__ float gelu_tanh(float x) {
    const float z = 0.7978845608028654f * (x + 0.044715f * x * x * x);
    const float e = __expf(2.0f * z);
    const float t = 1.0f - 2.0f * __builtin_amdgcn_rcpf(1.0f + e);
    return 0.5f * x * (1.0f + t);
}

__device__ __forceinline__ void transpose_item(const float* W, int N, int K, bf16* WT, int k0, int n0, int drow0, LAS float* scr, int lane) {
#pragma unroll 8
    for (int i = 0; i < 32; ++i) { const int kk = 2 * i + (lane >> 5); scr[kk * 33 + (lane & 31)] = W[(size_t)(k0 + kk) * N + n0 + (lane & 31)]; }
    asm volatile("s_waitcnt lgkmcnt(0)" ::: "memory");
    const int c = lane & 7;
#pragma unroll
    for (int j = 0; j < 4; ++j) { const int n = (lane >> 3) + 8 * j; const LAS float* s = scr + (8 * c) * 33 + n;
        u32x4 o; o.x = pk2(s[0 * 33], s[1 * 33]); o.y = pk2(s[2 * 33], s[3 * 33]); o.z = pk2(s[4 * 33], s[5 * 33]); o.w = pk2(s[6 * 33], s[7 * 33]);
        *(u32x4*)(WT + (size_t)(drow0 + n) * K + k0 + 8 * c) = o; }
    asm volatile("s_waitcnt lgkmcnt(0)" ::: "memory");
}
__device__ __forceinline__ int w1_drow(int n0) { return n0 < FF ? (n0 >> 7) * 256 + (n0 & 127) : ((n0 - FF) >> 7) * 256 + 128 + ((n0 - FF) & 127); }

__device__ __forceinline__ void phase_p0(const Args& a, LAS unsigned char* lds) {
    const int tid = ltid(), lane = tid & 63, wave = tid >> 6;
    unsigned char* ws = a.ws;
    if (lbid() < 144 || gridDim.x < 144) {
        for (int cg0 = lbid(); cg0 < 144; cg0 += gridDim.x) {
            LAS float* sil = (LAS float*)lds;
            LAS float* red = (LAS float*)(lds + 20480);
            for (int i = tid; i < 5 * 1024; i += NTHR) { const int r = i >> 10, k = i & 1023; const float v = r < 4 ? a.in[1][r * 1024 + k] : a.in[3][k]; sil[i] = pg8::silu_f(v); }
            __syncthreads();
            const int cl = tid & 15, ks = tid >> 4, j0 = cg0 * 64 + 4 * cl;
            const float* wa = a.in[4] + (size_t)(ks * 32) * NMODC + j0;
            f32x4 acc[5];
#pragma unroll
            for (int r = 0; r < 5; ++r) acc[r] = (f32x4){0.f, 0.f, 0.f, 0.f};
#pragma unroll 8
            for (int k = 0; k < 32; ++k) { const f32x4 w = *(const f32x4*)(wa + (size_t)k * NMODC);
#pragma unroll
                for (int r = 0; r < 5; ++r) acc[r] += w * sil[r * 1024 + ks * 32 + k]; }
#pragma unroll
            for (int r = 0; r < 5; ++r) *(LAS f32x4*)(red + (ks * 5 + r) * 64 + 4 * cl) = acc[r];
            __syncthreads();
            if (tid < 320) { const int r = tid >> 6, col = tid & 63; float s = a.in[5][cg0 * 64 + col];
                for (int k = 0; k < 32; ++k) s += red[(k * 5 + r) * 64 + col];
                ((float*)(ws + WS_MOD))[r * NMODC + cg0 * 64 + col] = s; }
            __syncthreads();
        }
    }
    LAS float* scr = (LAS float*)(lds + wave * 16384);
    const int gw = lbid() * NWAVES + wave, NGW = gridDim.x * NWAVES;
    constexpr int I_W1 = (D / 64) * (2 * FF / 32), I_W2 = (FF / 64) * (D / 32), I_IN = (D / 64) * (NIN / 32), I_OUT = (D / 64) * (D / 32);
    constexpr int NITEMS = 2 * I_W1 + 2 * I_W2 + I_IN + I_OUT;
    for (int it = gw; it < NITEMS; it += NGW) {
        int r = it; const float* W; bf16* WT; int N, K; bool isw1 = false;
        if (r < I_W1) { W = a.in[7]; WT = (bf16*)(ws + WS_W1A); N = 2 * FF; K = D; isw1 = true; }
        else if ((r -= I_W1) < I_W2) { W = a.in[8]; WT = (bf16*)(ws + WS_W2A); N = D; K = FF; }
        else if ((r -= I_W2) < I_IN) { W = a.in[9]; WT = (bf16*)(ws + WS_WIN); N = NIN; K = D; }
        else if ((r -= I_IN) < I_OUT) { W = a.in[13]; WT = (bf16*)(ws + WS_WOUT); N = D; K = D; }
        else if ((r -= I_OUT) < I_W1) { W = a.in[14]; WT = (bf16*)(ws + WS_W1B); N = 2 * FF; K = D; isw1 = true; }
        else { r -= I_W1; W = a.in[15]; WT = (bf16*)(ws + WS_W2B); N = D; K = FF; }
        const int nblk = N / 32, kb = r / nblk, nb = r - kb * nblk, n0 = 32 * nb;
        transpose_item(W, N, K, WT, 64 * kb, n0, isw1 ? w1_drow(n0) : n0, scr, lane);
    }
}

__device__ __forceinline__ void phase_normmod(const float* xl, const float* xc, int nrows, const float* g, const float* mod, int shift_slot, bf16* H) {
    const int tid = ltid(), lane = tid & 63, gw = lbid() * NWAVES + (tid >> 6), NGW = gridDim.x * NWAVES;
    f32x4 gv[4];
#pragma unroll
    for (int j = 0; j < 4; ++j) gv[j] = *(const f32x4*)(g + 4 * lane + 256 * j);
    for (int row = gw; row < nrows; row += NGW) {
        const float* xr = row < MX ? xl + (size_t)row * D : xc + (size_t)(row - MX) * D;
        const float* mrow = mod + (row < MX ? (row >> 12) : 4) * NMODC + shift_slot * D;
        f32x4 v[4]; float ss = 0.f;
#pragma unroll
        for (int j = 0; j < 4; ++j) { v[j] = *(const f32x4*)(xr + 4 * lane + 256 * j); ss += (v[j].x * v[j].x + v[j].y * v[j].y) + (v[j].z * v[j].z + v[j].w * v[j].w); }
        const float rstd = 1.0f / sqrtf(wave_sum(ss) * (1.0f / D) + EPS);
#pragma unroll
        for (int j = 0; j < 4; ++j) {
            const f32x4 sh = *(const f32x4*)(mrow + 4 * lane + 256 * j), sc = *(const f32x4*)(mrow + D + 4 * lane + 256 * j);
            const f32x4 y = (v[j] * rstd) * gv[j] * (sc + 1.0f) + sh;
            u32x2 o; o.x = pk2(y.x, y.y); o.y = pk2(y.z, y.w);
            *(u32x2*)(H + (size_t)row * D + 4 * lane + 256 * j) = o;
        }
    }
}
__device__ __forceinline__ void phase_final(float* xo, const float* g) {
    const int tid = ltid(), lane = tid & 63, gw = lbid() * NWAVES + (tid >> 6), NGW = gridDim.x * NWAVES;
    f32x4 gv[4];
#pragma unroll
    for (int j = 0; j < 4; ++j) gv[j] = *(const f32x4*)(g + 4 * lane + 256 * j);
    for (int row = gw; row < MX; row += NGW) {
        float* xr = xo + (size_t)row * D;
        f32x4 v[4]; float ss = 0.f;
#pragma unroll
        for (int j = 0; j < 4; ++j) { v[j] = *(const f32x4*)(xr + 4 * lane + 256 * j); ss += (v[j].x * v[j].x + v[j].y * v[j].y) + (v[j].z * v[j].z + v[j].w * v[j].w); }
        const float rstd = 1.0f / sqrtf(wave_sum(ss) * (1.0f / D) + EPS);
#pragma unroll
        for (int j = 0; j < 4; ++j) *(f32x4*)(xr + 4 * lane + 256 * j) = (v[j] * rstd) * gv[j];
    }
}

__device__ __forceinline__ void tile_load(const bf16* base, int pitch, int tp, int dg, float (&v)[2][2][8]) {
#pragma unroll
    for (int tk = 0; tk < 2; ++tk)
#pragma unroll
        for (int h = 0; h < 2; ++h) { const u32x4 r = *(const u32x4*)(base + (size_t)(2 * tp + tk) * pitch + 64 * h + 8 * dg);
            v[tk][h][0] = bf_lo(r.x); v[tk][h][1] = bf_hi(r.x); v[tk][h][2] = bf_lo(r.y); v[tk][h][3] = bf_hi(r.y);
            v[tk][h][4] = bf_lo(r.z); v[tk][h][5] = bf_hi(r.z); v[tk][h][6] = bf_lo(r.w); v[tk][h][7] = bf_hi(r.w); }
}
__device__ __forceinline__ void tile_rope(float (&v)[2][2][8], int pos0, int dg) {
#pragma unroll
    for (int tk = 0; tk < 2; ++tk) { const int n = pos0 + tk; const float p = (dg < 4) ? (float)(n >> 6) : (float)(n & 63);
#pragma unroll
        for (int i = 0; i < 8; ++i) { const int fi = 8 * (dg & 3) + i; const float fr = exp2f(-(float)fi * (13.287712379549449f / 32.0f)); const float ang = p * fr;
            float sn, cs; __sincosf(ang, &sn, &cs);
            const float t1 = v[tk][0][i], t2 = v[tk][1][i]; v[tk][0][i] = t1 * cs - t2 * sn; v[tk][1][i] = t1 * sn + t2 * cs; } }
}
__device__ __forceinline__ void tile_write_T(LAS bf16* T, int tp, int dg, const float (&v)[2][2][8], float w0, float w1) {
#pragma unroll
    for (int h = 0; h < 2; ++h)
#pragma unroll
        for (int i = 0; i < 8; ++i) { const int d = 64 * h + 8 * dg + i; const int c = (tp >> 2) ^ ((d >> 3) & 7);
            ((LAS unsigned*)T)[d * (TP / 2) + c * 4 + (tp & 3)] = pk2(v[0][h][i] * w0, v[1][h][i] * w1); }
}
__device__ __forceinline__ void tile_write_R(LAS bf16* T, int tp, int dg, const float (&v)[2][2][8]) {
#pragma unroll
    for (int tk = 0; tk < 2; ++tk)
#pragma unroll
        for (int h = 0; h < 2; ++h) { u32x4 o; o.x = pk2(v[tk][h][0], v[tk][h][1]); o.y = pk2(v[tk][h][2], v[tk][h][3]); o.z = pk2(v[tk][h][4], v[tk][h][5]); o.w = pk2(v[tk][h][6], v[tk][h][7]);
            *(LAS u32x4*)(T + (2 * tp + tk) * TP + 64 * h + 8 * dg) = o; }
}
__device__ __forceinline__ bf16x8 frag_R(const LAS bf16* T, int row, int ks, int q) { return *(const LAS bf16x8*)(T + row * TP + 32 * ks + 8 * q); }
__device__ __forceinline__ bf16x8 frag_T(const LAS bf16* T, int row, int ks, int q) { return *(const LAS bf16x8*)(T + row * TP + (((4 * ks + q) ^ ((row >> 3) & 7)) << 3)); }
template <bool SWZ>
__device__ __forceinline__ void strip_mma(f32x4 (&acc)[8], const bf16x8 (&xa)[4], const LAS bf16* Y, int r, int q) {
#pragma unroll
    for (int ks = 0; ks < 4; ++ks)
#pragma unroll
        for (int nt = 0; nt < 8; ++nt) { const bf16x8 yb = SWZ ? frag_T(Y, 16 * nt + r, ks, q) : frag_R(Y, 16 * nt + r, ks, q);
            acc[nt] = __builtin_amdgcn_mfma_f32_16x16x32_bf16(yb, xa[ks], acc[nt], 0, 0, 0); }
}

__device__ __forceinline__ void r1_state_item(const Args& a, LAS unsigned char* lds, int it) {
    const int tid = ltid(), lane = tid & 63, wave = tid >> 6, r = lane & 15, q = lane >> 4, tp = tid >> 3, dg = tid & 7;
    const bf16* P = (const bf16*)(a.ws + WS_ACT); bf16* U = (bf16*)(a.ws + WS_H);
    int h, row0, pos0; bool rope;
    if (it < 512) { const int bh = it >> 5, c = it & 31; h = bh & 3; row0 = (bh >> 2) * SEQ + c * CH; pos0 = c * CH; rope = true; }
    else { const int j = it - 512, bh = j >> 1, cc = j & 1; h = bh & 3; row0 = MX + (bh >> 2) * CTXL + cc * CH; pos0 = 0; rope = false; }
    const float lgf = -__expf(a.in[10][h]) * 1.4426950408889634f, lgb = -__expf(a.in[10][4 + h]) * 1.4426950408889634f;
    LAS bf16* Kt = (LAS bf16*)lds; LAS bf16* Vf = (LAS bf16*)(lds + TILE_B); LAS bf16* Vb = (LAS bf16*)(lds + 2 * TILE_B);
    {
        float v[2][2][8];
        tile_load(P + (size_t)row0 * NIN + 512 + h * 128, NIN, tp, dg, v);
        if (rope) tile_rope(v, pos0 + 2 * tp, dg);
        tile_write_T(Kt, tp, dg, v, 0.08838834764831845f, 0.08838834764831845f);
        tile_load(P + (size_t)row0 * NIN + 1024 + h * 128, NIN, tp, dg, v);
        const float t0 = (float)(2 * tp), t1 = t0 + 1.0f;
        tile_write_T(Vf, tp, dg, v, exp2f((127.0f - t0) * lgf), exp2f((127.0f - t1) * lgf));
        tile_write_T(Vb, tp, dg, v, exp2f(t0 * lgb), exp2f(t1 * lgb));
    }
    __syncthreads();
    bf16x8 xf[4], xb[4];
#pragma unroll
    for (int ks = 0; ks < 4; ++ks) { xf[ks] = frag_T(Vf, 16 * wave + r, ks, q); xb[ks] = frag_T(Vb, 16 * wave + r, ks, q); }
    f32x4 af[8], ab[8];
#pragma unroll
    for (int nt = 0; nt < 8; ++nt) { af[nt] = (f32x4){0.f, 0.f, 0.f, 0.f}; ab[nt] = (f32x4){0.f, 0.f, 0.f, 0.f}; }
    strip_mma<true>(af, xf, Kt, r, q);
    strip_mma<true>(ab, xb, Kt, r, q);
    bf16* uf = U + ((size_t)(it * 2 + 0) * 128 + 16 * wave + r) * 128 + 4 * q;
    bf16* ub = U + ((size_t)(it * 2 + 1) * 128 + 16 * wave + r) * 128 + 4 * q;
#pragma unroll
    for (int nt = 0; nt < 8; ++nt) {
        u32x2 o; o.x = pk2(af[nt][0], af[nt][1]); o.y = pk2(af[nt][2], af[nt][3]); *(u32x2*)(uf + 16 * nt) = o;
        o.x = pk2(ab[nt][0], ab[nt][1]); o.y = pk2(ab[nt][2], ab[nt][3]); *(u32x2*)(ub + 16 * nt) = o;
    }
    __syncthreads();
}
__device__ __forceinline__ void r1_gmlp_item(const Args& a, LAS unsigned char* lds, int j) {
    const int tid = ltid(), lane = tid & 63, wave = tid >> 6, r = lane & 15, q = lane >> 4, tp = tid >> 3, dg = tid & 7;
    const bf16* P = (const bf16*)(a.ws + WS_ACT); bf16* MIX = (bf16*)(a.ws + WS_MIX);
    const int g = j & 3, bc = j >> 2, row0 = bc * CH;
    LAS bf16* Wsb = (LAS bf16*)lds; LAS bf16* Vn = (LAS bf16*)(lds + TILE_B);
    const float* Ws = a.in[11] + (size_t)g * CH * CH;
#pragma unroll
    for (int i = 0; i < 8; ++i) { const int p = (tid >> 5) + 16 * i, c4 = 4 * (tid & 31); const f32x4 w = *(const f32x4*)(Ws + p * CH + c4);
        u32x2 o; o.x = pk2(w.x, w.y); o.y = pk2(w.z, w.w); *(LAS u32x2*)(Wsb + p * TP + c4) = o; }
    {
        float v[2][2][8];
        tile_load(P + (size_t)row0 * NIN + 2560 + g * 128, NIN, tp, dg, v);
#pragma unroll
        for (int tk = 0; tk < 2; ++tk) {
            float s = 0.f;
#pragma unroll
            for (int h = 0; h < 2; ++h)
#pragma unroll
                for (int i = 0; i < 8; ++i) { v[tk][h][i] = gelu_tanh(v[tk][h][i]); s += v[tk][h][i]; }
            s += __shfl_xor(s, 1); s += __shfl_xor(s, 2); s += __shfl_xor(s, 4);
            const float mu = s * (1.0f / 128.0f); float qv = 0.f;
#pragma unroll
            for (int h = 0; h < 2; ++h)
#pragma unroll
                for (int i = 0; i < 8; ++i) { v[tk][h][i] -= mu; qv += v[tk][h][i] * v[tk][h][i]; }
            qv += __shfl_xor(qv, 1); qv += __shfl_xor(qv, 2); qv += __shfl_xor(qv, 4);
            const float rs = 1.0f / sqrtf(qv * (1.0f / 128.0f) + EPS);
#pragma unroll
            for (int h = 0; h < 2; ++h)
#pragma unroll
                for (int i = 0; i < 8; ++i) v[tk][h][i] *= rs;
        }
        tile_write_T(Vn, tp, dg, v, 1.0f, 1.0f);
    }
    __syncthreads();
    bf16x8 xa[4];
#pragma unroll
    for (int ks = 0; ks < 4; ++ks) xa[ks] = frag_R(Wsb, 16 * wave + r, ks, q);
    f32x4 acc[8];
#pragma unroll
    for (int nt = 0; nt < 8; ++nt) acc[nt] = (f32x4){0.f, 0.f, 0.f, 0.f};
    strip_mma<true>(acc, xa, Vn, r, q);
    const int p = 16 * wave + r; const float bs = a.in[12][g * CH + p];
    const bf16* up = P + (size_t)(row0 + p) * NIN + 2048 + g * 128 + 4 * q;
    bf16* op = MIX + (size_t)(row0 + p) * D + 512 + g * 128 + 4 * q;
#pragma unroll
    for (int nt = 0; nt < 8; ++nt) { const u32x2 uu = *(const u32x2*)(up + 16 * nt);
        const float o0 = gelu_tanh(bf_lo(uu.x)) * (acc[nt][0] + bs), o1 = gelu_tanh(bf_hi(uu.x)) * (acc[nt][1] + bs), o2 = gelu_tanh(bf_lo(uu.y)) * (acc[nt][2] + bs), o3 = gelu_tanh(bf_hi(uu.y)) * (acc[nt][3] + bs);
        u32x2 o; o.x = pk2(o0, o1); o.y = pk2(o2, o3); *(u32x2*)(op + 16 * nt) = o; }
    __syncthreads();
}
__device__ __forceinline__ void phase_r1(const Args& a, LAS unsigned char* lds) {
    for (int it = lbid(); it < 544 + 512; it += gridDim.x) { if (it < 544) r1_state_item(a, lds, it); else r1_gmlp_item(a, lds, it - 544); }
}
__device__ __forceinline__ void phase_r2(const Args& a) {
    bf16* U = (bf16*)(a.ws + WS_H);
    for (int gidx = lbid() * NTHR + ltid(); gidx < 16 * 2 * 4096; gidx += gridDim.x * NTHR) {
        const int bh = gidx >> 13, dir = (gidx >> 12) & 1, e4 = gidx & 4095, h = bh & 3;
        const float dec = __expf(-__expf(a.in[10][dir * 4 + h]) * 128.0f);
        const size_t eo = (size_t)dir * 16384 + 4 * e4;
        const u32x2 c0 = *(const u32x2*)(U + (size_t)(512 + bh * 2 + 0) * 32768 + eo), c1 = *(const u32x2*)(U + (size_t)(512 + bh * 2 + 1) * 32768 + eo);
        float s0, s1, s2, s3;
        if (dir == 0) { s0 = dec * bf_lo(c0.x) + bf_lo(c1.x); s1 = dec * bf_hi(c0.x) + bf_hi(c1.x); s2 = dec * bf_lo(c0.y) + bf_lo(c1.y); s3 = dec * bf_hi(c0.y) + bf_hi(c1.y); }
        else          { s0 = dec * bf_lo(c1.x) + bf_lo(c0.x); s1 = dec * bf_hi(c1.x) + bf_hi(c0.x); s2 = dec * bf_lo(c1.y) + bf_lo(c0.y); s3 = dec * bf_hi(c1.y) + bf_hi(c0.y); }
#pragma unroll 8
        for (int k = 0; k < NCH; ++k) { const int c = dir == 0 ? k : NCH - 1 - k;
            u32x2* p = (u32x2*)(U + (size_t)(bh * 32 + c) * 32768 + eo); const u32x2 t = *p;
            u32x2 o; o.x = pk2(s0, s1); o.y = pk2(s2, s3); *p = o;
            s0 = dec * s0 + bf_lo(t.x); s1 = dec * s1 + bf_hi(t.x); s2 = dec * s2 + bf_lo(t.y); s3 = dec * s3 + bf_hi(t.y); }
    }
}
__device__ __forceinline__ void r3_item(const Args& a, LAS unsigned char* lds, int it) {
    const int tid = ltid(), lane = tid & 63, wave = tid >> 6, r = lane & 15, q = lane >> 4, tp = tid >> 3, dg = tid & 7;
    const bf16* P = (const bf16*)(a.ws + WS_ACT); const bf16* S = (const bf16*)(a.ws + WS_H); bf16* MIX = (bf16*)(a.ws + WS_MIX);
    const int bh = it >> 5, c = it & 31, h = bh & 3, row0 = (bh >> 2) * SEQ + c * CH, pos0 = c * CH;
    const float lgf = -__expf(a.in[10][h]) * 1.4426950408889634f, lgb = -__expf(a.in[10][4 + h]) * 1.4426950408889634f;
    LAS bf16* Ks = (LAS bf16*)lds; LAS bf16* Vt = (LAS bf16*)(lds + TILE_B); LAS bf16* Sf = (LAS bf16*)(lds + 2 * TILE_B); LAS bf16* Sb = (LAS bf16*)(lds + 3 * TILE_B);
    {
        float v[2][2][8];
        tile_load(P + (size_t)row0 * NIN + 512 + h * 128, NIN, tp, dg, v);
        tile_rope(v, pos0 + 2 * tp, dg);
#pragma unroll
        for (int tk = 0; tk < 2; ++tk)
#pragma unroll
            for (int hh = 0; hh < 2; ++hh)
#pragma unroll
                for (int i = 0; i < 8; ++i) v[tk][hh][i] *= 0.08838834764831845f;
        tile_write_R(Ks, tp, dg, v);
        tile_load(P + (size_t)row0 * NIN + 1024 + h * 128, NIN, tp, dg, v);
        tile_write_T(Vt, tp, dg, v, 1.0f, 1.0f);
        const bf16* sf = S + (size_t)(it * 2 + 0) * 16384; const bf16* sb = S + (size_t)(it * 2 + 1) * 16384;
#pragma unroll
        for (int i = 0; i < 4; ++i) { const int id = tid + NTHR * i, rr = id >> 4, c8 = id & 15;
            *(LAS u32x4*)(Sf + rr * TP + 8 * c8) = *(const u32x4*)(sf + rr * 128 + 8 * c8);
            *(LAS u32x4*)(Sb + rr * TP + 8 * c8) = *(const u32x4*)(sb + rr * 128 + 8 * c8); }
    }
    const int irow = 16 * wave + r;
    bf16x8 xq[4];
    {
        const bf16* qp = P + (size_t)(row0 + irow) * NIN + h * 128 + 8 * q;
        float f[4][8];
#pragma unroll
        for (int ks = 0; ks < 4; ++ks) { const u32x4 rw = *(const u32x4*)(qp + 32 * ks);
            f[ks][0] = bf_lo(rw.x); f[ks][1] = bf_hi(rw.x); f[ks][2] = bf_lo(rw.y); f[ks][3] = bf_hi(rw.y); f[ks][4] = bf_lo(rw.z); f[ks][5] = bf_hi(rw.z); f[ks][6] = bf_lo(rw.w); f[ks][7] = bf_hi(rw.w); }
        const int n = pos0 + irow;
#pragma unroll
        for (int ks = 0; ks < 2; ++ks) { const float p = ks == 0 ? (float)(n >> 6) : (float)(n & 63);
#pragma unroll
            for (int i = 0; i < 8; ++i) { const int fi = 8 * q + i; const float fr = exp2f(-(float)fi * (13.287712379549449f / 32.0f)); float sn, cs; __sincosf(p * fr, &sn, &cs);
                const float t1 = f[ks][i], t2 = f[ks + 2][i]; f[ks][i] = t1 * cs - t2 * sn; f[ks + 2][i] = t1 * sn + t2 * cs; } }
#pragma unroll
        for (int ks = 0; ks < 4; ++ks) { u32x4 o; o.x = pk2(f[ks][0], f[ks][1]); o.y = pk2(f[ks][2], f[ks][3]); o.z = pk2(f[ks][4], f[ks][5]); o.w = pk2(f[ks][6], f[ks][7]); xq[ks] = __builtin_bit_cast(bf16x8, o); }
    }
    __syncthreads();
    f32x4 acc[8];
#pragma unroll
    for (int nt = 0; nt < 8; ++nt) acc[nt] = (f32x4){0.f, 0.f, 0.f, 0.f};
    strip_mma<false>(acc, xq, Ks, r, q);
    __syncthreads();
    LAS bf16* Ps = Ks;
#pragma unroll
    for (int nt = 0; nt < 8; ++nt) { float pv[4];
#pragma unroll
        for (int jj = 0; jj < 4; ++jj) { const int df = irow - (16 * nt + 4 * q + jj);
            const float m = df > 0 ? exp2f((float)df * lgf) : (df < 0 ? exp2f((float)(-df) * lgb) : 2.0f); pv[jj] = acc[nt][jj] * m; }
        u32x2 o; o.x = pk2(pv[0], pv[1]); o.y = pk2(pv[2], pv[3]); *(LAS u32x2*)(Ps + irow * TP + 16 * nt + 4 * q) = o; }
    const float xif = exp2f((float)(irow + 1) * lgf), xib = exp2f((float)(128 - irow) * lgb);
#pragma unroll
    for (int nt = 0; nt < 8; ++nt) acc[nt] = (f32x4){0.f, 0.f, 0.f, 0.f};
    strip_mma<false>(acc, xq, Sb, r, q);
    { const float rt = xib / xif;
#pragma unroll
      for (int nt = 0; nt < 8; ++nt) acc[nt] *= rt; }
    strip_mma<false>(acc, xq, Sf, r, q);
#pragma unroll
    for (int nt = 0; nt < 8; ++nt) acc[nt] *= xif;
    {
        bf16x8 xp[4];
#pragma unroll
        for (int ks = 0; ks < 4; ++ks) xp[ks] = frag_R(Ps, irow, ks, q);
        strip_mma<true>(acc, xp, Vt, r, q);
    }
    float ss = 0.f;
#pragma unroll
    for (int nt = 0; nt < 8; ++nt) ss += (acc[nt][0] * acc[nt][0] + acc[nt][1] * acc[nt][1]) + (acc[nt][2] * acc[nt][2] + acc[nt][3] * acc[nt][3]);
    ss += __shfl_xor(ss, 16); ss += __shfl_xor(ss, 32);
    const float rstd = 1.0f / sqrtf(ss * (1.0f / 128.0f) + EPS);
    const bf16* gp = P + (size_t)(row0 + irow) * NIN + 1536 + h * 128 + 4 * q;
    bf16* op = MIX + (size_t)(row0 + irow) * D + h * 128 + 4 * q;
#pragma unroll
    for (int nt = 0; nt < 8; ++nt) { const u32x2 gg = *(const u32x2*)(gp + 16 * nt);
        u32x2 o; o.x = pk2(acc[nt][0] * rstd * pg8::silu_f(bf_lo(gg.x)), acc[nt][1] * rstd * pg8::silu_f(bf_hi(gg.x)));
        o.y = pk2(acc[nt][2] * rstd * pg8::silu_f(bf_lo(gg.y)), acc[nt][3] * rstd * pg8::silu_f(bf_hi(gg.y)));
        *(u32x2*)(op + 16 * nt) = o; }
    __syncthreads();
}

#ifndef ONLY
#define ONLY (-1)
#endif
#define ON(p) (ONLY < 0 || ONLY == (p))
enum { PH_P0 = 0, PH_P1, PH_G1, PH_G2, PH_P2, PH_G3, PH_R1, PH_R2, PH_R3, PH_G4, PH_P3, PH_G5, PH_G6, PH_F, PH_N };

__global__ void __launch_bounds__(NTHR, 2) mk_fwd(Args a) {
    extern __shared__ __attribute__((aligned(16))) unsigned char lds_raw[];
    LAS unsigned char* lds = (LAS unsigned char*)lds_raw;
    cg::grid_group grid = cg::this_grid();
    unsigned char* ws = a.ws;
    const float* mod = (const float*)(ws + WS_MOD);
    bf16* H = (bf16*)(ws + WS_H); bf16* ACT = (bf16*)(ws + WS_ACT); bf16* MIX = (bf16*)(ws + WS_MIX);
    float* X1C = (float*)(ws + WS_X1C);
    const int G = gridDim.x;
    for (int ph = a.ph_lo; ph < a.ph_hi; ++ph) {
        const int bx = lbid();
        switch (ph) {
        case PH_P0: if constexpr (ON(PH_P0)) phase_p0(a, lds); break;
        case PH_P1: if constexpr (ON(PH_P1)) phase_normmod(a.in[0], a.in[2], MT, a.in[6], mod, 0, H); break;
        case PH_P2: if constexpr (ON(PH_P1)) phase_normmod(a.out, X1C, MT, a.in[6] + D, mod, 3, H); break;
        case PH_P3: if constexpr (ON(PH_P1)) phase_normmod(a.out, X1C, MX, a.in[6] + 2 * D, mod, 6, H); break;
        case PH_G1: case PH_G5: if constexpr (ON(PH_G1)) {
            const int M = ph == PH_G1 ? MT : MX;
            pg8::Gemm g{H, (const bf16*)(ws + (ph == PH_G1 ? WS_W1A : WS_W1B)), M, 2 * FF, D}; pg8::StaticOrder S; S.init(M, 2 * FF, G, bx);
            pg8::EpiSwiglu E{ACT, FF};
            pg8::gemm_phase<pg8::EpiSwiglu, pg8::StaticOrder, true, true>(lds, g, S, E);
        } break;
        case PH_G2: case PH_G4: case PH_G6: if constexpr (ON(PH_G2)) {
            pg8::Gemm g; pg8::EpiResid E;
            if (ph == PH_G2)      { g = pg8::Gemm{ACT, (const bf16*)(ws + WS_W2A), MT, D, FF}; E = pg8::EpiResid{a.in[0], a.in[2], a.out, X1C, mod, 2, 0.5f}; }
            else if (ph == PH_G4) { g = pg8::Gemm{MIX, (const bf16*)(ws + WS_WOUT), MX, D, D}; E = pg8::EpiResid{a.out, X1C, a.out, X1C, mod, 5, 1.0f}; }
            else                  { g = pg8::Gemm{ACT, (const bf16*)(ws + WS_W2B), MX, D, FF}; E = pg8::EpiResid{a.out, X1C, a.out, X1C, mod, 8, 0.5f}; }
            pg8::StaticOrder S; S.init(g.M, g.N, G, bx);
            pg8::gemm_phase<pg8::EpiResid, pg8::StaticOrder, true, true>(lds, g, S, E);
        } break;
        case PH_G3: if constexpr (ON(PH_G3)) {
            pg8::Gemm g{H, (const bf16*)(ws + WS_WIN), MT, NIN, D}; pg8::StaticOrder S; S.init(MT, NIN, G, bx);
            pg8::EpiPlainBf16 E{ACT, NIN};
            pg8::gemm_phase<pg8::EpiPlainBf16, pg8::StaticOrder, true, true>(lds, g, S, E);
        } break;
        case PH_R1: if constexpr (ON(PH_R1)) phase_r1(a, lds); break;
        case PH_R2: if constexpr (ON(PH_R2)) phase_r2(a); break;
        case PH_R3: if constexpr (ON(PH_R3)) for (int it = bx; it < 512; it += G) r3_item(a, lds, it); break;
        case PH_F: if constexpr (ON(PH_F)) phase_final(a.out, a.in[16]); break;
        default: break;
        }
        if (ph + 1 < a.ph_hi) {
            asm volatile("s_waitcnt vmcnt(0) lgkmcnt(0)" ::: "memory");
            __syncthreads();
            if (ltid() < 64) asm volatile("buffer_wbl2 sc1\n\ts_waitcnt vmcnt(0)" ::: "memory");
            grid.sync();
            asm volatile("buffer_inv sc1\n\ts_waitcnt vmcnt(0)" ::: "memory");
        }
    }
}

extern "C" void kernel_launch(void* const* d_in, const int* in_sizes, int n_in, void* d_out, int out_size, void* d_ws, size_t ws_size, hipStream_t stream) {
    static int grid = 0;
    if (grid == 0) {
        if (n_in != 17 || out_size != MX * D || ws_size < WS_END) { fprintf(stderr, "kernel_launch: unexpected shapes (n_in %d out %d ws %zu)\n", n_in, out_size, ws_size); grid = -1; return; }
        int dev = 0, cus = 0, per_cu = 0;
        hipGetDevice(&dev); hipDeviceGetAttribute(&cus, hipDeviceAttributeMultiprocessorCount, dev);
        if (hipFuncSetAttribute((const void*)mk_fwd, hipFuncAttributeMaxDynamicSharedMemorySize, LDS_BYTES) != hipSuccess) { fprintf(stderr, "kernel_launch: hipFuncSetAttribute failed\n"); grid = -1; return; }
        if (hipOccupancyMaxActiveBlocksPerMultiprocessor(&per_cu, (const void*)mk_fwd, NTHR, LDS_BYTES) != hipSuccess || per_cu < 1) { fprintf(stderr, "kernel_launch: occupancy query failed (%d)\n", per_cu); (void)hipGetLastError(); per_cu = 1; }
        grid = cus * per_cu;
        fprintf(stderr, "kernel_launch: %d CUs x %d = grid %d\n", cus, per_cu, grid);
    }
    if (grid < 0) return;
    Args a{};
    for (int i = 0; i < 17; ++i) a.in[i] = (const float*)d_in[i];
    a.out = (float*)d_out; a.ws = (unsigned char*)d_ws; a.ph_lo = 0; a.ph_hi = PH_N;
#ifndef N_LAUNCH_PER_PHASE
    void* args[] = {&a};
    const hipError_t e = hipLaunchCooperativeKernel((const void*)mk_fwd, dim3(grid), dim3(NTHR), args, LDS_BYTES, stream);
    if (e != hipSuccess) fprintf(stderr, "kernel_launch: cooperative launch failed: %s (grid %d)\n", hipGetErrorString(e), grid);
#else
    for (int p = 0; p < PH_N; ++p) { if (!((PHASE_MASK >> p) & 1)) continue; a.ph_lo = p; a.ph_hi = p + 1; hipLaunchKernelGGL(mk_fwd, dim3(grid), dim3(NTHR), LDS_BYTES, stream, a); }
#endif
}
```

```cpp
#include <hip/hip_runtime.h>
#include <hip/hip_cooperative_groups.h>
#include <cstdio>
#include <cstdint>
namespace cg = cooperative_groups;
__device__ __forceinline__ int ltid() { int t = threadIdx.x; asm volatile("" : "+v"(t)); return t; }
__device__ __forceinline__ int lbid() { int t = blockIdx.x; asm volatile("" : "+s"(t)); return t; }
typedef float f32x2_t __attribute__((ext_vector_type(2))); typedef __bf16 bf16x2_t __attribute__((ext_vector_type(2)));
__device__ __forceinline__ unsigned cvtpk(float lo, float hi) { f32x2_t v = {lo, hi}; bf16x2_t b = __builtin_convertvector(v, bf16x2_t); return __builtin_bit_cast(unsigned, b); }
namespace pg8 {
#define PG8_LAS __attribute__((address_space(3)))
typedef unsigned short bf16_t;
typedef short bf16x8 __attribute__((ext_vector_type(8)));
typedef float f32x4 __attribute__((ext_vector_type(4)));
typedef unsigned u32x4 __attribute__((ext_vector_type(4)));
constexpr int BM = 256, BK = 64, HALF = 128, HTB = HALF * BK * 2  , STAGE_BYTES = 8 * HTB, NXCD = 8, WGM = 8;

__host__ __device__ __forceinline__ int lds_byte(int r, int c) { const int st = (r >> 4) * 2 + (c >> 5), rr = r & 15, cc = c & 31, ob = rr * 64 + cc * 2; return st * 1024 + (ob ^ (((ob >> 9) & 1) << 5)); }
__host__ __device__ __forceinline__ void stage_rc(int b, int& R, int& C) { const int st = b / 1024, sb = b % 1024, swz = sb ^ (((sb >> 9) & 1) << 5); R = (st >> 1) * 16 + swz / 64; C = (st & 1) * 32 + (swz % 64) / 2; }
__host__ __device__ __forceinline__ int perm32(int rho) { const int n = rho >> 4, i = rho & 15; return 8 * (i >> 2) + 4 * n + (i & 3); }

struct Unit { int pm, pn; };
struct Gemm { const bf16_t* A; const bf16_t* Bt; int M, N, K; };

struct StaticOrder {
    int nM, nN, nwg, G, c;
    __host__ __device__ void init(int M, int N, int G_, int c_) { nM = M / BM; nN = N / BM; nwg = nM * nN; G = G_; c = c_; }
    __host__ __device__ bool next(int i, Unit& u) const {
        const long L = (long)i * G + c; if (L >= nwg) return false;
        int wgid = (int)L; { const int q = nwg / NXCD, r = nwg % NXCD, xcd = wgid % NXCD, off = wgid / NXCD; wgid = (xcd < r ? xcd * (q + 1) : r * (q + 1) + (xcd - r) * q) + off; }
        const int nig = WGM * nN, gid = wgid / nig, fm = gid * WGM, gsz = (nM - fm) < WGM ? (nM - fm) : WGM;
        u.pm = fm + ((wgid % nig) % gsz); u.pn = (wgid % nig) / gsz; return true;
    }
    __device__ __forceinline__ void a_ready(const Unit&) const {}
    __device__ __forceinline__ void done(const Unit&) const {}
};

__device__ __forceinline__ unsigned cvt_pk_bf16(float lo, float hi) { unsigned r; asm volatile("v_cvt_pk_bf16_f32 %0, %1, %2" : "=v"(r) : "v"(lo), "v"(hi)); return r; }
typedef float f32x2 __attribute__((ext_vector_type(2)));

__device__ __forceinline__ float silu_f(float x) { return x * __builtin_amdgcn_rcpf(1.0f + __expf(-x)); }

struct EpiSwiglu {
    static constexpr bool PERM = true, AFTER_DRAIN = false;
    bf16_t* O; int ldc;
    __device__ __forceinline__ void operator()(const f32x4 (&acc)[2][2][4][2], const Unit& u, int wr, int wc, int fr, int fq) const {
        const int row0 = u.pm * BM + wr * 64 + fr, col0 = u.pn * HALF + wc * 32 + 8 * fq;
#pragma unroll
        for (int ai = 0; ai < 2; ++ai)
#pragma unroll
            for (int m = 0; m < 4; ++m) {
                bf16_t* rowp = O + (size_t)(row0 + ai * HALF + m * 16) * ldc + col0;
                const f32x4 g0 = acc[ai][0][m][0], g1 = acc[ai][0][m][1], u0 = acc[ai][1][m][0], u1 = acc[ai][1][m][1];
                u32x4 w;
                w.x = ::cvtpk(silu_f(g0[0]) * u0[0], silu_f(g0[1]) * u0[1]); w.y = ::cvtpk(silu_f(g0[2]) * u0[2], silu_f(g0[3]) * u0[3]);
                w.z = ::cvtpk(silu_f(g1[0]) * u1[0], silu_f(g1[1]) * u1[1]); w.w = ::cvtpk(silu_f(g1[2]) * u1[2], silu_f(g1[3]) * u1[3]);
                *(u32x4*)rowp = w;
            }
    }
};
struct EpiPlainBf16 {
    static constexpr bool PERM = true, AFTER_DRAIN = false;
    bf16_t* O; int ldc;
    __device__ __forceinline__ void operator()(const f32x4 (&acc)[2][2][4][2], const Unit& u, int wr, int wc, int fr, int fq) const {
        const int row0 = u.pm * BM + wr * 64 + fr, col0 = u.pn * BM + wc * 32 + 8 * fq;
#pragma unroll
        for (int ai = 0; ai < 2; ++ai)
#pragma unroll
            for (int m = 0; m < 4; ++m) {
                bf16_t* rowp = O + (size_t)(row0 + ai * HALF + m * 16) * ldc + col0;
#pragma unroll
                for (int bj = 0; bj < 2; ++bj) {
                    const f32x4 v0 = acc[ai][bj][m][0], v1 = acc[ai][bj][m][1];
                    u32x4 w; w.x = ::cvtpk(v0[0], v0[1]); w.y = ::cvtpk(v0[2], v0[3]); w.z = ::cvtpk(v1[0], v1[1]); w.w = ::cvtpk(v1[2], v1[3]);
                    *(u32x4*)(rowp + bj * HALF) = w;
                }
            }
    }
};
struct EpiResid {
    static constexpr bool PERM = false, AFTER_DRAIN = false;
    const float* xin_lat; const float* xin_ctx; float* out_lat; float* out_ctx; const float* mod; int slot; float coef;
    __device__ __forceinline__ void operator()(const f32x4 (&acc)[2][2][4][2], const Unit& u, int wr, int wc, int fr, int fq) const {
        const bool isctx = u.pm >= 64; const int mb = isctx ? 4 : (u.pm >> 4);
        const float* xin = isctx ? xin_ctx : xin_lat; float* out = isctx ? out_ctx : out_lat;
        const int row0 = (isctx ? u.pm - 64 : u.pm) * BM + wr * 64 + fr, col0 = u.pn * BM + wc * 32 + 4 * fq;
        const float* mrow = mod + mb * 9216 + slot * 1024 + col0;
        f32x4 gv[2][2];
#pragma unroll
        for (int bj = 0; bj < 2; ++bj)
#pragma unroll
            for (int n = 0; n < 2; ++n) gv[bj][n] = *(const f32x4*)(mrow + bj * HALF + n * 16) * coef;
#pragma unroll
        for (int ai = 0; ai < 2; ++ai)
#pragma unroll
            for (int m = 0; m < 4; ++m) { const size_t off = (size_t)(row0 + ai * HALF + m * 16) * 1024 + col0;
#pragma unroll
                for (int bj = 0; bj < 2; ++bj)
#pragma unroll
                    for (int n = 0; n < 2; ++n) { const f32x4 xi = *(const f32x4*)(xin + off + bj * HALF + n * 16);
                        *(f32x4*)(out + off + bj * HALF + n * 16) = xi + gv[bj][n] * acc[ai][bj][m][n]; } }
    }
};

template <class Epi, class Sched, bool ALIGN_EPI = false, bool SP2 = false>
__device__ __forceinline__ void gemm_phase(PG8_LAS unsigned char* lds, const Gemm g, const Sched& S, const Epi& E) {
    const int tid = ltid(), wid = __builtin_amdgcn_readfirstlane(tid >> 6), lane = tid & 63, wr = wid >> 2, wc = wid & 3, fr = lane & 15, fq = lane >> 4;
    const int K = g.K, nt = K / BK;
    unsigned voffA[2], voffB[2];
#pragma unroll
    for (int i = 0; i < 2; ++i) { int R, C; stage_rc(tid * 16 + i * 8192, R, C); const int Rb = Epi::PERM ? ((R & ~31) + perm32(R & 31)) : R;
        voffA[i] = (unsigned)(R * K + C) * 2u; voffB[i] = (unsigned)(Rb * K + C) * 2u; }
    const size_t kstep = (size_t)(BK * 2);
    const size_t hstep = (size_t)HALF * K * 2;
    const size_t tstep = 2 * hstep;
    const unsigned ldsw = (unsigned)wid * 1024u;
    const int aoff = lds_byte(wr * 64 + fr, fq * 8), boff = lds_byte(wc * 32 + fr, fq * 8);
#define PG8_SA(b, h) (((b) * 2 + (h)) * HTB)
#define PG8_SB(b, h) ((4 + (b) * 2 + (h)) * HTB)
#define PG8_STAGE(bufoff, gbase, voff) do { _Pragma("unroll") for (int _i = 0; _i < 2; ++_i) \
        __builtin_amdgcn_global_load_lds((const unsigned*)((const char*)(gbase) + (voff)[_i]), (PG8_LAS unsigned*)(lds + (bufoff) + ldsw + _i * 8192), 16, 0, 0); } while (0)
#define PG8_LDA(dst, b, h) do { _Pragma("unroll") for (int m = 0; m < 4; ++m) _Pragma("unroll") for (int k = 0; k < 2; ++k) dst[m][k] = *(const PG8_LAS bf16x8*)(lds + PG8_SA(b, h) + aoff + m * 2048 + k * 1024); } while (0)
#define PG8_LDB(dst, b, h) do { _Pragma("unroll") for (int n = 0; n < 2; ++n) _Pragma("unroll") for (int k = 0; k < 2; ++k) dst[n][k] = *(const PG8_LAS bf16x8*)(lds + PG8_SB(b, h) + boff + n * 2048 + k * 1024); } while (0)
#define PG8_MMA(ai, bj, At, Bt) do { __builtin_amdgcn_s_setprio(1); _Pragma("unroll") for (int m = 0; m < 4; ++m) _Pragma("unroll") for (int n = 0; n < 2; ++n) _Pragma("unroll") for (int k = 0; k < 2; ++k) \
        acc[ai][bj][m][n] = __builtin_amdgcn_mfma_f32_16x16x32_bf16(Bt[n][k], At[m][k], acc[ai][bj][m][n], 0, 0, 0); __builtin_amdgcn_s_setprio(0); } while (0)
#define PG8_WAIT_V(n) asm volatile("s_waitcnt vmcnt(" #n ")" ::: "memory")
#define PG8_WAIT_L(n) asm volatile("s_waitcnt lgkmcnt(" #n ")" ::: "memory")
#define PG8_BAR __builtin_amdgcn_s_barrier()
#define PG8_SCHED __builtin_amdgcn_sched_barrier(0)
    Unit cur, nxt; int ui = 0;
    if (!S.next(0, cur)) return;
    f32x4 acc[2][2][4][2];
#pragma unroll
    for (int a = 0; a < 2; ++a)
#pragma unroll
        for (int b = 0; b < 2; ++b)
#pragma unroll
            for (int m = 0; m < 4; ++m)
#pragma unroll
                for (int n = 0; n < 2; ++n) acc[a][b][m][n] = (f32x4){0.f, 0.f, 0.f, 0.f};
    bf16x8 At[4][2], B0[2][2], B1[2][2];
    const char* cA = (const char*)g.A + (size_t)cur.pm * tstep; const char* cB = (const char*)g.Bt + (size_t)cur.pn * tstep;
    S.a_ready(cur);
    if constexpr (SP2) {
        PG8_STAGE(PG8_SB(0, 0), cB, voffB); PG8_STAGE(PG8_SB(0, 1), cB + hstep, voffB); PG8_STAGE(PG8_SA(0, 0), cA, voffA); PG8_STAGE(PG8_SA(0, 1), cA + hstep, voffA);
        if (wr == 1) PG8_BAR;
        PG8_WAIT_V(2); PG8_BAR;
        PG8_STAGE(PG8_SB(1, 0), cB + kstep, voffB); PG8_STAGE(PG8_SA(1, 0), cA + kstep, voffA); PG8_STAGE(PG8_SB(1, 1), cB + hstep + kstep, voffB);
        PG8_WAIT_V(6); PG8_BAR;
    } else {
        PG8_STAGE(PG8_SB(0, 0), cB, voffB); PG8_STAGE(PG8_SA(0, 0), cA, voffA); PG8_STAGE(PG8_SB(0, 1), cB + hstep, voffB); PG8_STAGE(PG8_SA(0, 1), cA + hstep, voffA);
        if (wr == 1) PG8_BAR;
        PG8_WAIT_V(4); PG8_BAR;
        PG8_STAGE(PG8_SB(1, 0), cB + kstep, voffB); PG8_STAGE(PG8_SA(1, 0), cA + kstep, voffA); PG8_STAGE(PG8_SB(1, 1), cB + hstep + kstep, voffB);
        PG8_WAIT_V(6); PG8_BAR;
    }
    for (;;) {
        const bool has_next = S.next(ui + 1, nxt);
        const char* nA = has_next ? (const char*)g.A + (size_t)nxt.pm * tstep : cA; const char* nB = has_next ? (const char*)g.Bt + (size_t)nxt.pn * tstep : cB;
        for (int t = 0; t < nt; t += 2) {
            const bool last = (t == nt - 2);
            const char* a1 = cA + (size_t)(t + 1) * kstep;
            const char* a2 = last ? nA : cA + (size_t)(t + 2) * kstep; const char* b2 = last ? nB : cB + (size_t)(t + 2) * kstep;
            const char* a3 = a2 + kstep; const char* b3 = b2 + kstep;
            if (last && has_next) S.a_ready(nxt);
            if constexpr (SP2) {
            PG8_LDB(B0, 0, 0); PG8_LDB(B1, 0, 1); PG8_SCHED; PG8_LDA(At, 0, 0); PG8_STAGE(PG8_SA(1, 1), a1 + hstep, voffA);
            PG8_WAIT_V(8); PG8_WAIT_L(0); PG8_BAR; PG8_MMA(0, 0, At, B0); PG8_MMA(0, 1, At, B1); PG8_BAR; PG8_SCHED;
            PG8_LDA(At, 0, 1); PG8_STAGE(PG8_SB(0, 0), b2, voffB); PG8_STAGE(PG8_SB(0, 1), b2 + hstep, voffB); PG8_STAGE(PG8_SA(0, 0), a2, voffA);
            PG8_WAIT_V(8); PG8_WAIT_L(0); PG8_BAR; PG8_MMA(1, 0, At, B0); PG8_MMA(1, 1, At, B1); PG8_BAR; PG8_SCHED;
            PG8_LDB(B0, 1, 0); PG8_LDB(B1, 1, 1); PG8_SCHED; PG8_LDA(At, 1, 0); PG8_STAGE(PG8_SA(0, 1), a2 + hstep, voffA);
            PG8_WAIT_V(8); PG8_WAIT_L(0); PG8_BAR; PG8_MMA(0, 0, At, B0); PG8_MMA(0, 1, At, B1); PG8_BAR; PG8_SCHED;
            PG8_LDA(At, 1, 1); PG8_STAGE(PG8_SB(1, 0), b3, voffB); PG8_STAGE(PG8_SB(1, 1), b3 + hstep, voffB); PG8_STAGE(PG8_SA(1, 0), a3, voffA);
            PG8_WAIT_V(8); PG8_WAIT_L(0); PG8_BAR; PG8_MMA(1, 0, At, B0); PG8_MMA(1, 1, At, B1); PG8_BAR; PG8_SCHED;
            } else {
            PG8_LDB(B0, 0, 0); PG8_SCHED; PG8_LDA(At, 0, 0); PG8_STAGE(PG8_SA(1, 1), a1 + hstep, voffA);
            PG8_WAIT_L(8); PG8_BAR; PG8_WAIT_L(0); PG8_MMA(0, 0, At, B0); PG8_BAR; PG8_SCHED;
            PG8_LDB(B1, 0, 1); PG8_STAGE(PG8_SB(0, 0), b2, voffB);
            PG8_BAR; PG8_WAIT_L(0); PG8_MMA(0, 1, At, B1); PG8_BAR;
            PG8_LDA(At, 0, 1); PG8_STAGE(PG8_SA(0, 0), a2, voffA);
            PG8_BAR; PG8_WAIT_L(0); PG8_MMA(1, 0, At, B0); PG8_BAR; PG8_SCHED;
            PG8_STAGE(PG8_SB(0, 1), b2 + hstep, voffB);
            PG8_WAIT_V(6); PG8_BAR; PG8_MMA(1, 1, At, B1); PG8_BAR;
            PG8_LDB(B0, 1, 0); PG8_SCHED; PG8_LDA(At, 1, 0); PG8_STAGE(PG8_SA(0, 1), a2 + hstep, voffA);
            PG8_WAIT_L(8); PG8_BAR; PG8_WAIT_L(0); PG8_MMA(0, 0, At, B0); PG8_BAR; PG8_SCHED;
            PG8_LDB(B1, 1, 1); PG8_STAGE(PG8_SB(1, 0), b3, voffB);
            PG8_BAR; PG8_WAIT_L(0); PG8_MMA(0, 1, At, B1); PG8_BAR;
            PG8_LDA(At, 1, 1); PG8_STAGE(PG8_SA(1, 0), a3, voffA);
            PG8_BAR; PG8_WAIT_L(0); PG8_MMA(1, 0, At, B0); PG8_BAR; PG8_SCHED;
            PG8_STAGE(PG8_SB(1, 1), b3 + hstep, voffB);
            PG8_WAIT_V(6); PG8_BAR; PG8_MMA(1, 1, At, B1); PG8_BAR;
            }
        }
        if constexpr (ALIGN_EPI) { if (wr == 0) PG8_BAR; }
        if constexpr (!Epi::AFTER_DRAIN) { E(acc, cur, wr, wc, fr, fq); S.done(cur); }
        if (!has_next) break;
#pragma unroll
        for (int a = 0; a < 2; ++a)
#pragma unroll
            for (int b = 0; b < 2; ++b)
#pragma unroll
                for (int m = 0; m < 4; ++m)
#pragma unroll
                    for (int n = 0; n < 2; ++n) acc[a][b][m][n] = (f32x4){0.f, 0.f, 0.f, 0.f};
        cur = nxt; cA = nA; cB = nB; ++ui;
        if constexpr (ALIGN_EPI) { if (wr == 1) PG8_BAR; }
    }
    PG8_WAIT_V(0);
    if constexpr (!ALIGN_EPI) { if (wr == 0) PG8_BAR; }
    PG8_BAR;
    if constexpr (Epi::AFTER_DRAIN) { E.fused(acc, cur, wr, wc, fr, fq, lds, wid, lane); S.done(cur); }
#undef PG8_SA
#undef PG8_SB
#undef PG8_STAGE
#undef PG8_LDA
#undef PG8_LDB
#undef PG8_MMA
#undef PG8_WAIT_V
#undef PG8_WAIT_L
#undef PG8_BAR
#undef PG8_SCHED
}
}
#define XB_TMO      128
#define XB_XCNT(j)  (256  + 64 * (j))
#define XB_XSUB(j)  (1280 + 64 * (j))
#define XB_XGEN(j)  (2304 + 64 * (j))
#define XB_TOP      3328
#define XB_TOPGEN   3392
#define XCD_BAR_WORDS 3456
#define XB_SPIN_CAP (1u << 18)
#define LAS __attribute__((address_space(3)))

__device__ __forceinline__ unsigned xb_ld(unsigned* p)              { return __hip_atomic_load(p, __ATOMIC_RELAXED, __HIP_MEMORY_SCOPE_AGENT); }
__device__ __forceinline__ unsigned xb_add(unsigned* p, unsigned v) { return __hip_atomic_fetch_add(p, v, __ATOMIC_RELAXED, __HIP_MEMORY_SCOPE_AGENT); }
__device__ __forceinline__ unsigned xb_xcc_id() { return (unsigned)__builtin_amdgcn_s_getreg((3 << 11) | 20) & 0xFu; }
#define XB_SPIN(cond, bar) do { unsigned _sp = 0; while (cond) { __builtin_amdgcn_s_sleep(1); \
    if ((++_sp & 255u) == 0u) { if (xb_ld(&(bar)[XB_TMO])) break; if (_sp > XB_SPIN_CAP) { atomicAdd(&(bar)[XB_TMO], 1u); break; } } } } while (0)

struct XcdBarrier {
    unsigned* bar; unsigned x;
    volatile LAS unsigned* st;
};

__device__ __forceinline__ XcdBarrier xcd_barrier_post(unsigned* bar, volatile LAS unsigned* st) {
    XcdBarrier b; b.bar = bar; b.x = xb_xcc_id(); b.st = st;
    if (threadIdx.x == 0) (void)xb_add(&bar[XB_XCNT(b.x)], 1u);
    return b;
}
__device__ __forceinline__ void xcd_barrier_complete(unsigned* bar, unsigned x, unsigned& nloc, unsigned& nx) {
    const unsigned G = gridDim.x * gridDim.y * gridDim.z;
    unsigned sum, cnt, mine, sp = 0u;
    for (;;) {
        sum = 0u; cnt = 0u; mine = 0u;
#pragma unroll
        for (unsigned j = 0; j < 16; ++j) { const unsigned c = xb_ld(&bar[XB_XCNT(j)]); sum += c; cnt += (c > 0u) ? 1u : 0u; mine = (j == x) ? c : mine; }
        if (sum == G) break;
        __builtin_amdgcn_s_sleep(1);
        if ((++sp & 255u) == 0u) { if (xb_ld(&bar[XB_TMO])) break; if (sp > XB_SPIN_CAP) { atomicAdd(&bar[XB_TMO], 1u); break; } }
    }
    nloc = mine > 0u ? mine : 1u; nx = cnt > 0u ? cnt : 1u;
}

__device__ __forceinline__ void xcd_barrier(const XcdBarrier& b) {
    asm volatile("s_waitcnt vmcnt(0)" ::: "memory");
    __syncthreads();
    if (threadIdx.x == 0) {
        unsigned* bar = b.bar;
        __builtin_amdgcn_s_waitcnt(0);
        unsigned nloc = b.st[0], nx = b.st[1];
        if (nloc == 0u) { xcd_barrier_complete(bar, b.x, nloc, nx); b.st[0] = nloc; b.st[1] = nx; }
        const unsigned old = xb_add(&bar[XB_XSUB(b.x)], 1u);
        const unsigned gen = old / nloc;
        if (old + 1u == (gen + 1u) * nloc) {
            __builtin_amdgcn_fence(__ATOMIC_RELEASE, "agent");
            asm volatile("s_waitcnt vmcnt(0)" ::: "memory");
            const unsigned og = xb_add(&bar[XB_TOP], 1u);
            const unsigned tg = og / nx;
            if (og + 1u == (tg + 1u) * nx) xb_add(&bar[XB_TOPGEN], 1u);
            else XB_SPIN(xb_ld(&bar[XB_TOPGEN]) == tg, bar);
            __builtin_amdgcn_fence(__ATOMIC_ACQUIRE, "agent");
            xb_add(&bar[XB_XGEN(b.x)], 1u);
            asm volatile("s_waitcnt vmcnt(0)" ::: "memory");
        } else {
            XB_SPIN(xb_ld(&bar[XB_XGEN(b.x)]) == gen, bar);
            __builtin_amdgcn_fence(__ATOMIC_ACQUIRE, "agent");
            asm volatile("s_waitcnt vmcnt(0)" ::: "memory");
        }
    }
    __syncthreads();
}

#define LAS __attribute__((address_space(3)))
typedef unsigned short bf16;
typedef float f32x4 __attribute__((ext_vector_type(4)));
typedef short bf16x8 __attribute__((ext_vector_type(8)));
typedef unsigned u32x4 __attribute__((ext_vector_type(4)));
typedef unsigned u32x2 __attribute__((ext_vector_type(2)));

constexpr int D = 1024, NB = 4, SEQ = 4096, CTXL = 256, MX = NB * SEQ, MC = NB * CTXL, MT = MX + MC;
constexpr int FF = 2816, NIN = 3072, NMODC = 9 * D;
constexpr int CH = 128, NCH = SEQ / CH, NHEAD = 4;
constexpr float EPS = 1e-6f;
constexpr int NTHR = 512, NWAVES = 8;
constexpr int LDS_BYTES = 147456;
constexpr int TP = 136;
constexpr int TILE_B = 128 * TP * 2;
static_assert(4 * TILE_B <= LDS_BYTES, "lds");

constexpr size_t MiB = 1u << 20;
constexpr size_t WS_MOD = 0;
constexpr size_t WS_BAR = 512 * 1024;
constexpr size_t WS_W1A = 1 * MiB, WS_W2A = 12 * MiB, WS_WIN = 18 * MiB, WS_WOUT = 24 * MiB, WS_W1B = 26 * MiB, WS_W2B = 37 * MiB;
constexpr size_t WS_X1C = 43 * MiB;
constexpr size_t WS_H = 47 * MiB;
constexpr size_t WS_MIX = 81 * MiB;
constexpr size_t WS_ACT = 113 * MiB;
constexpr size_t WS_END = 215 * MiB;

struct Args { const float* in[17]; float* out; unsigned char* ws; int ph_lo, ph_hi; };

__device__ __forceinline__ unsigned pk2(float lo, float hi) { return cvtpk(lo, hi); }
__device__ __forceinline__ float bf_lo(unsigned w) { return __uint_as_float(w << 16); }
__device__ __forceinline__ float bf_hi(unsigned w) { return __uint_as_float(w & 0xffff0000u); }
__device__ __forceinline__ float wave_sum(float v) {
#pragma unroll
    for (int o = 1; o < 64; o <<= 1) v += __shfl_xor(v, o);
    return v;
}
__device__ __forceinline__ float gelu_tanh(float x) {
    const float z = 0.7978845608028654f * (x + 0.044715f * x * x * x);
    const float e = __expf(2.0f * z);
    const float t = 1.0f - 2.0f * __builtin_amdgcn_rcpf(1.0f + e);
    return 0.5f * x * (1.0f + t);
}

__device__ __forceinline__ void transpose_item(const float* W, int N, int K, bf16* WT, int k0, int n0, int drow0, LAS float* scr, int lane) {
#pragma unroll 8
    for (int i = 0; i < 32; ++i) { const int kk = 2 * i + (lane >> 5); scr[kk * 33 + (lane & 31)] = W[(size_t)(k0 + kk) * N + n0 + (lane & 31)]; }
    asm volatile("s_waitcnt lgkmcnt(0)" ::: "memory");
    const int c = lane & 7;
#pragma unroll
    for (int j = 0; j < 4; ++j) { const int n = (lane >> 3) + 8 * j; const LAS float* s = scr + (8 * c) * 33 + n;
        u32x4 o; o.x = pk2(s[0 * 33], s[1 * 33]); o.y = pk2(s[2 * 33], s[3 * 33]); o.z = pk2(s[4 * 33], s[5 * 33]); o.w = pk2(s[6 * 33], s[7 * 33]);
        *(u32x4*)(WT + (size_t)(drow0 + n) * K + k0 + 8 * c) = o; }
    asm volatile("s_waitcnt lgkmcnt(0)" ::: "memory");
}
__device__ __forceinline__ int w1_drow(int n0) { return n0 < FF ? (n0 >> 7) * 256 + (n0 & 127) : ((n0 - FF) >> 7) * 256 + 128 + ((n0 - FF) & 127); }

__device__ __forceinline__ void phase_p0(const Args& a, LAS unsigned char* lds) {
    const int tid = ltid(), lane = tid & 63, wave = tid >> 6;
    unsigned char* ws = a.ws;
    if (lbid() < 144 || gridDim.x < 144) {
        for (int cg0 = lbid(); cg0 < 144; cg0 += gridDim.x) {
            LAS float* sil = (LAS float*)lds;
            LAS float* red = (LAS float*)(lds + 20480);
            for (int i = tid; i < 5 * 1024; i += NTHR) { const int r = i >> 10, k = i & 1023; const float v = r < 4 ? a.in[1][r * 1024 + k] : a.in[3][k]; sil[i] = pg8::silu_f(v); }
            __syncthreads();
            const int cl = tid & 15, ks = tid >> 4, j0 = cg0 * 64 + 4 * cl;
            const float* wa = a.in[4] + (size_t)(ks * 32) * NMODC + j0;
            f32x4 acc[5];
#pragma unroll
            for (int r = 0; r < 5; ++r) acc[r] = (f32x4){0.f, 0.f, 0.f, 0.f};
#pragma unroll 8
            for (int k = 0; k < 32; ++k) { const f32x4 w = *(const f32x4*)(wa + (size_t)k * NMODC);
#pragma unroll
                for (int r = 0; r < 5; ++r) acc[r] += w * sil[r * 1024 + ks * 32 + k]; }
#pragma unroll
            for (int r = 0; r < 5; ++r) *(LAS f32x4*)(red + (ks * 5 + r) * 64 + 4 * cl) = acc[r];
            __syncthreads();
            if (tid < 320) { const int r = tid >> 6, col = tid & 63; float s = a.in[5][cg0 * 64 + col];
                for (int k = 0; k < 32; ++k) s += red[(k * 5 + r) * 64 + col];
                ((float*)(ws + WS_MOD))[r * NMODC + cg0 * 64 + col] = s; }
            __syncthreads();
        }
    }
    LAS float* scr = (LAS float*)(lds + wave * 16384);
    const int gw = lbid() * NWAVES + wave, NGW = gridDim.x * NWAVES;
    constexpr int I_W1 = (D / 64) * (2 * FF / 32), I_W2 = (FF / 64) * (D / 32), I_IN = (D / 64) * (NIN / 32), I_OUT = (D / 64) * (D / 32);
    constexpr int NITEMS = 2 * I_W1 + 2 * I_W2 + I_IN + I_OUT;
    for (int it = gw; it < NITEMS; it += NGW) {
        int r = it; const float* W; bf16* WT; int N, K; bool isw1 = false;
        if (r < I_W1) { W = a.in[7]; WT = (bf16*)(ws + WS_W1A); N = 2 * FF; K = D; isw1 = true; }
        else if ((r -= I_W1) < I_W2) { W = a.in[8]; WT = (bf16*)(ws + WS_W2A); N = D; K = FF; }
        else if ((r -= I_W2) < I_IN) { W = a.in[9]; WT = (bf16*)(ws + WS_WIN); N = NIN; K = D; }
        else if ((r -= I_IN) < I_OUT) { W = a.in[13]; WT = (bf16*)(ws + WS_WOUT); N = D; K = D; }
        else if ((r -= I_OUT) < I_W1) { W = a.in[14]; WT = (bf16*)(ws + WS_W1B); N = 2 * FF; K = D; isw1 = true; }
        else { r -= I_W1; W = a.in[15]; WT = (bf16*)(ws + WS_W2B); N = D; K = FF; }
        const int nblk = N / 32, kb = r / nblk, nb = r - kb * nblk, n0 = 32 * nb;
        transpose_item(W, N, K, WT, 64 * kb, n0, isw1 ? w1_drow(n0) : n0, scr, lane);
    }
}

__device__ __forceinline__ void phase_normmod(const float* xl, const float* xc, int nrows, const float* g, const float* mod, int shift_slot, bf16* H) {
    const int tid = ltid(), lane = tid & 63, gw = lbid() * NWAVES + (tid >> 6), NGW = gridDim.x * NWAVES;
    f32x4 gv[4];
#pragma unroll
    for (int j = 0; j < 4; ++j) gv[j] = *(const f32x4*)(g + 4 * lane + 256 * j);
    for (int row = gw; row < nrows; row += NGW) {
        const float* xr = row < MX ? xl + (size_t)row * D : xc + (size_t)(row - MX) * D;
        const float* mrow = mod + (row < MX ? (row >> 12) : 4) * NMODC + shift_slot * D;
        f32x4 v[4]; float ss = 0.f;
#pragma unroll
        for (int j = 0; j < 4; ++j) { v[j] = *(const f32x4*)(xr + 4 * lane + 256 * j); ss += (v[j].x * v[j].x + v[j].y * v[j].y) + (v[j].z * v[j].z + v[j].w * v[j].w); }
        const float rstd = 1.0f / sqrtf(wave_sum(ss) * (1.0f / D) + EPS);
#pragma unroll
        for (int j = 0; j < 4; ++j) {
            const f32x4 sh = *(const f32x4*)(mrow + 4 * lane + 256 * j), sc = *(const f32x4*)(mrow + D + 4 * lane + 256 * j);
            const f32x4 y = (v[j] * rstd) * gv[j] * (sc + 1.0f) + sh;
            u32x2 o; o.x = pk2(y.x, y.y); o.y = pk2(y.z, y.w);
            *(u32x2*)(H + (size_t)row * D + 4 * lane + 256 * j) = o;
        }
    }
}
__device__ __forceinline__ void phase_final(float* xo, const float* g) {
    const int tid = ltid(), lane = tid & 63, gw = lbid() * NWAVES + (tid >> 6), NGW = gridDim.x * NWAVES;
    f32x4 gv[4];
#pragma unroll
    for (int j = 0; j < 4; ++j) gv[j] = *(const f32x4*)(g + 4 * lane + 256 * j);
    for (int row = gw; row < MX; row += NGW) {
        float* xr = xo + (size_t)row * D;
        f32x4 v[4]; float ss = 0.f;
#pragma unroll
        for (int j = 0; j < 4; ++j) { v[j] = *(const f32x4*)(xr + 4 * lane + 256 * j); ss += (v[j].x * v[j].x + v[j].y * v[j].y) + (v[j].z * v[j].z + v[j].w * v[j].w); }
        const float rstd = 1.0f / sqrtf(wave_sum(ss) * (1.0f / D) + EPS);
#pragma unroll
        for (int j = 0; j < 4; ++j) *(f32x4*)(xr + 4 * lane + 256 * j) = (v[j] * rstd) * gv[j];
    }
}

__device__ __forceinline__ void tile_load(const bf16* base, int pitch, int tp, int dg, float (&v)[2][2][8]) {
#pragma unroll
    for (int tk = 0; tk < 2; ++tk)
#pragma unroll
        for (int h = 0; h < 2; ++h) { const u32x4 r = *(const u32x4*)(base + (size_t)(2 * tp + tk) * pitch + 64 * h + 8 * dg);
            v[tk][h][0] = bf_lo(r.x); v[tk][h][1] = bf_hi(r.x); v[tk][h][2] = bf_lo(r.y); v[tk][h][3] = bf_hi(r.y);
            v[tk][h][4] = bf_lo(r.z); v[tk][h][5] = bf_hi(r.z); v[tk][h][6] = bf_lo(r.w); v[tk][h][7] = bf_hi(r.w); }
}
__device__ __forceinline__ void tile_rope(float (&v)[2][2][8], int pos0, int dg) {
#pragma unroll
    for (int tk = 0; tk < 2; ++tk) { const int n = pos0 + tk; const float p = (dg < 4) ? (float)(n >> 6) : (float)(n & 63);
#pragma unroll
        for (int i = 0; i < 8; ++i) { const int fi = 8 * (dg & 3) + i; const float fr = exp2f(-(float)fi * (13.287712379549449f / 32.0f)); const float ang = p * fr;
            float sn, cs; __sincosf(ang, &sn, &cs);
            const float t1 = v[tk][0][i], t2 = v[tk][1][i]; v[tk][0][i] = t1 * cs - t2 * sn; v[tk][1][i] = t1 * sn + t2 * cs; } }
}
__device__ __forceinline__ void tile_write_T(LAS bf16* T, int tp, int dg, const float (&v)[2][2][8], float w0, float w1) {
#pragma unroll
    for (int h = 0; h < 2; ++h)
#pragma unroll
        for (int i = 0; i < 8; ++i) { const int d = 64 * h + 8 * dg + i; const int c = (tp >> 2) ^ ((d >> 3) & 7);
            ((LAS unsigned*)T)[d * (TP / 2) + c * 4 + (tp & 3)] = pk2(v[0][h][i] * w0, v[1][h][i] * w1); }
}
__device__ __forceinline__ void tile_write_R(LAS bf16* T, int tp, int dg, const float (&v)[2][2][8]) {
#pragma unroll
    for (int tk = 0; tk < 2; ++tk)
#pragma unroll
        for (int h = 0; h < 2; ++h) { u32x4 o; o.x = pk2(v[tk][h][0], v[tk][h][1]); o.y = pk2(v[tk][h][2], v[tk][h][3]); o.z = pk2(v[tk][h][4], v[tk][h][5]); o.w = pk2(v[tk][h][6], v[tk][h][7]);
            *(LAS u32x4*)(T + (2 * tp + tk) * TP + 64 * h + 8 * dg) = o; }
}
__device__ __forceinline__ bf16x8 frag_R(const LAS bf16* T, int row, int ks, int q) { return *(const LAS bf16x8*)(T + row * TP + 32 * ks + 8 * q); }
__device__ __forceinline__ bf16x8 frag_T(const LAS bf16* T, int row, int ks, int q) { return *(const LAS bf16x8*)(T + row * TP + (((4 * ks + q) ^ ((row >> 3) & 7)) << 3)); }
template <bool SWZ>
__device__ __forceinline__ void strip_mma(f32x4 (&acc)[8], const bf16x8 (&xa)[4], const LAS bf16* Y, int r, int q) {
#pragma unroll
    for (int ks = 0; ks < 4; ++ks)
#pragma unroll
        for (int nt = 0; nt < 8; ++nt) { const bf16x8 yb = SWZ ? frag_T(Y, 16 * nt + r, ks, q) : frag_R(Y, 16 * nt + r, ks, q);
            acc[nt] = __builtin_amdgcn_mfma_f32_16x16x32_bf16(yb, xa[ks], acc[nt], 0, 0, 0); }
}

__device__ __forceinline__ void r1_state_item(const Args& a, LAS unsigned char* lds, int it) {
    const int tid = ltid(), lane = tid & 63, wave = tid >> 6, r = lane & 15, q = lane >> 4, tp = tid >> 3, dg = tid & 7;
    const bf16* P = (const bf16*)(a.ws + WS_ACT); bf16* U = (bf16*)(a.ws + WS_H);
    int h, row0, pos0; bool rope;
    if (it < 512) { const int bh = it >> 5, c = it & 31; h = bh & 3; row0 = (bh >> 2) * SEQ + c * CH; pos0 = c * CH; rope = true; }
    else { const int j = it - 512, bh = j >> 1, cc = j & 1; h = bh & 3; row0 = MX + (bh >> 2) * CTXL + cc * CH; pos0 = 0; rope = false; }
    const float lgf = -__expf(a.in[10][h]) * 1.4426950408889634f, lgb = -__expf(a.in[10][4 + h]) * 1.4426950408889634f;
    LAS bf16* Kt = (LAS bf16*)lds; LAS bf16* Vf = (LAS bf16*)(lds + TILE_B); LAS bf16* Vb = (LAS bf16*)(lds + 2 * TILE_B);
    {
        float v[2][2][8];
        tile_load(P + (size_t)row0 * NIN + 512 + h * 128, NIN, tp, dg, v);
        if (rope) tile_rope(v, pos0 + 2 * tp, dg);
        tile_write_T(Kt, tp, dg, v, 0.08838834764831845f, 0.08838834764831845f);
        tile_load(P + (size_t)row0 * NIN + 1024 + h * 128, NIN, tp, dg, v);
        const float t0 = (float)(2 * tp), t1 = t0 + 1.0f;
        tile_write_T(Vf, tp, dg, v, exp2f((127.0f - t0) * lgf), exp2f((127.0f - t1) * lgf));
        tile_write_T(Vb, tp, dg, v, exp2f(t0 * lgb), exp2f(t1 * lgb));
    }
    __syncthreads();
    bf16x8 xf[4], xb[4];
#pragma unroll
    for (int ks = 0; ks < 4; ++ks) { xf[ks] = frag_T(Vf, 16 * wave + r, ks, q); xb[ks] = frag_T(Vb, 16 * wave + r, ks, q); }
    f32x4 af[8], ab[8];
#pragma unroll
    for (int nt = 0; nt < 8; ++nt) { af[nt] = (f32x4){0.f, 0.f, 0.f, 0.f}; ab[nt] = (f32x4){0.f, 0.f, 0.f, 0.f}; }
    strip_mma<true>(af, xf, Kt, r, q);
    strip_mma<true>(ab, xb, Kt, r, q);
    bf16* uf = U + ((size_t)(it * 2 + 0) * 128 + 16 * wave + r) * 128 + 4 * q;
    bf16* ub = U + ((size_t)(it * 2 + 1) * 128 + 16 * wave + r) * 128 + 4 * q;
#pragma unroll
    for (int nt = 0; nt < 8; ++nt) {
        u32x2 o; o.x = pk2(af[nt][0], af[nt][1]); o.y = pk2(af[nt][2], af[nt][3]); *(u32x2*)(uf + 16 * nt) = o;
        o.x = pk2(ab[nt][0], ab[nt][1]); o.y = pk2(ab[nt][2], ab[nt][3]); *(u32x2*)(ub + 16 * nt) = o;
    }
    __syncthreads();
}
__device__ __forceinline__ void r1_gmlp_item(const Args& a, LAS unsigned char* lds, int j) {
    const int tid = ltid(), lane = tid & 63, wave = tid >> 6, r = lane & 15, q = lane >> 4, tp = tid >> 3, dg = tid & 7;
    const bf16* P = (const bf16*)(a.ws + WS_ACT); bf16* MIX = (bf16*)(a.ws + WS_MIX);
    const int g = j & 3, bc = j >> 2, row0 = bc * CH;
    LAS bf16* Wsb = (LAS bf16*)lds; LAS bf16* Vn = (LAS bf16*)(lds + TILE_B);
    const float* Ws = a.in[11] + (size_t)g * CH * CH;
#pragma unroll
    for (int i = 0; i < 8; ++i) { const int p = (tid >> 5) + 16 * i, c4 = 4 * (tid & 31); const f32x4 w = *(const f32x4*)(Ws + p * CH + c4);
        u32x2 o; o.x = pk2(w.x, w.y); o.y = pk2(w.z, w.w); *(LAS u32x2*)(Wsb + p * TP + c4) = o; }
    {
        float v[2][2][8];
        tile_load(P + (size_t)row0 * NIN + 2560 + g * 128, NIN, tp, dg, v);
#pragma unroll
        for (int tk = 0; tk < 2; ++tk) {
            float s = 0.f;
#pragma unroll
            for (int h = 0; h < 2; ++h)
#pragma unroll
                for (int i = 0; i < 8; ++i) { v[tk][h][i] = gelu_tanh(v[tk][h][i]); s += v[tk][h][i]; }
            s += __shfl_xor(s, 1); s += __shfl_xor(s, 2); s += __shfl_xor(s, 4);
            const float mu = s * (1.0f / 128.0f); float qv = 0.f;
#pragma unroll
            for (int h = 0; h < 2; ++h)
#pragma unroll
                for (int i = 0; i < 8; ++i) { v[tk][h][i] -= mu; qv += v[tk][h][i] * v[tk][h][i]; }
            qv += __shfl_xor(qv, 1); qv += __shfl_xor(qv, 2); qv += __shfl_xor(qv, 4);
            const float rs = 1.0f / sqrtf(qv * (1.0f / 128.0f) + EPS);
#pragma unroll
            for (int h = 0; h < 2; ++h)
#pragma unroll
                for (int i = 0; i < 8; ++i) v[tk][h][i] *= rs;
        }
        tile_write_T(Vn, tp, dg, v, 1.0f, 1.0f);
    }
    __syncthreads();
    bf16x8 xa[4];
#pragma unroll
    for (int ks = 0; ks < 4; ++ks) xa[ks] = frag_R(Wsb, 16 * wave + r, ks, q);
    f32x4 acc[8];
#pragma unroll
    for (int nt = 0; nt < 8; ++nt) acc[nt] = (f32x4){0.f, 0.f, 0.f, 0.f};
    strip_mma<true>(acc, xa, Vn, r, q);
    const int p = 16 * wave + r; const float bs = a.in[12][g * CH + p];
    const bf16* up = P + (size_t)(row0 + p) * NIN + 2048 + g * 128 + 4 * q;
    bf16* op = MIX + (size_t)(row0 + p) * D + 512 + g * 128 + 4 * q;
#pragma unroll
    for (int nt = 0; nt < 8; ++nt) { const u32x2 uu = *(const u32x2*)(up + 16 * nt);
        const float o0 = gelu_tanh(bf_lo(uu.x)) * (acc[nt][0] + bs), o1 = gelu_tanh(bf_hi(uu.x)) * (acc[nt][1] + bs), o2 = gelu_tanh(bf_lo(uu.y)) * (acc[nt][2] + bs), o3 = gelu_tanh(bf_hi(uu.y)) * (acc[nt][3] + bs);
        u32x2 o; o.x = pk2(o0, o1); o.y = pk2(o2, o3); *(u32x2*)(op + 16 * nt) = o; }
    __syncthreads();
}
__device__ __forceinline__ void phase_r1(const Args& a, LAS unsigned char* lds) {
    for (int it = lbid(); it < 544 + 512; it += gridDim.x) { if (it < 544) r1_state_item(a, lds, it); else r1_gmlp_item(a, lds, it - 544); }
}
__device__ __forceinline__ void phase_r2(const Args& a) {
    bf16* U = (bf16*)(a.ws + WS_H);
    for (int gidx = lbid() * NTHR + ltid(); gidx < 16 * 2 * 4096; gidx += gridDim.x * NTHR) {
        const int bh = gidx >> 13, dir = (gidx >> 12) & 1, e4 = gidx & 4095, h = bh & 3;
        const float dec = __expf(-__expf(a.in[10][dir * 4 + h]) * 128.0f);
        const size_t eo = (size_t)dir * 16384 + 4 * e4;
        const u32x2 c0 = *(const u32x2*)(U + (size_t)(512 + bh * 2 + 0) * 32768 + eo), c1 = *(const u32x2*)(U + (size_t)(512 + bh * 2 + 1) * 32768 + eo);
        float s0, s1, s2, s3;
        if (dir == 0) { s0 = dec * bf_lo(c0.x) + bf_lo(c1.x); s1 = dec * bf_hi(c0.x) + bf_hi(c1.x); s2 = dec * bf_lo(c0.y) + bf_lo(c1.y); s3 = dec * bf_hi(c0.y) + bf_hi(c1.y); }
        else          { s0 = dec * bf_lo(c1.x) + bf_lo(c0.x); s1 = dec * bf_hi(c1.x) + bf_hi(c0.x); s2 = dec * bf_lo(c1.y) + bf_lo(c0.y); s3 = dec * bf_hi(c1.y) + bf_hi(c0.y); }
#pragma unroll 8
        for (int k = 0; k < NCH; ++k) { const int c = dir == 0 ? k : NCH - 1 - k;
            u32x2* p = (u32x2*)(U + (size_t)(bh * 32 + c) * 32768 + eo); const u32x2 t = *p;
            u32x2 o; o.x = pk2(s0, s1); o.y = pk2(s2, s3); *p = o;
            s0 = dec * s0 + bf_lo(t.x); s1 = dec * s1 + bf_hi(t.x); s2 = dec * s2 + bf_lo(t.y); s3 = dec * s3 + bf_hi(t.y); }
    }
}
__device__ __forceinline__ void r3_item(const Args& a, LAS unsigned char* lds, int it) {
    const int tid = ltid(), lane = tid & 63, wave = tid >> 6, r = lane & 15, q = lane >> 4, tp = tid >> 3, dg = tid & 7;
    const bf16* P = (const bf16*)(a.ws + WS_ACT); const bf16* S = (const bf16*)(a.ws + WS_H); bf16* MIX = (bf16*)(a.ws + WS_MIX);
    const int bh = it >> 5, c = it & 31, h = bh & 3, row0 = (bh >> 2) * SEQ + c * CH, pos0 = c * CH;
    const float lgf = -__expf(a.in[10][h]) * 1.4426950408889634f, lgb = -__expf(a.in[10][4 + h]) * 1.4426950408889634f;
    LAS bf16* Ks = (LAS bf16*)lds; LAS bf16* Vt = (LAS bf16*)(lds + TILE_B); LAS bf16* Sf = (LAS bf16*)(lds + 2 * TILE_B); LAS bf16* Sb = (LAS bf16*)(lds + 3 * TILE_B);
    {
        float v[2][2][8];
        tile_load(P + (size_t)row0 * NIN + 512 + h * 128, NIN, tp, dg, v);
        tile_rope(v, pos0 + 2 * tp, dg);
#pragma unroll
        for (int tk = 0; tk < 2; ++tk)
#pragma unroll
            for (int hh = 0; hh < 2; ++hh)
#pragma unroll
                for (int i = 0; i < 8; ++i) v[tk][hh][i] *= 0.08838834764831845f;
        tile_write_R(Ks, tp, dg, v);
        tile_load(P + (size_t)row0 * NIN + 1024 + h * 128, NIN, tp, dg, v);
        tile_write_T(Vt, tp, dg, v, 1.0f, 1.0f);
        const bf16* sf = S + (size_t)(it * 2 + 0) * 16384; const bf16* sb = S + (size_t)(it * 2 + 1) * 16384;
#pragma unroll
        for (int i = 0; i < 4; ++i) { const int id = tid + NTHR * i, rr = id >> 4, c8 = id & 15;
            *(LAS u32x4*)(Sf + rr * TP + 8 * c8) = *(const u32x4*)(sf + rr * 128 + 8 * c8);
            *(LAS u32x4*)(Sb + rr * TP + 8 * c8) = *(const u32x4*)(sb + rr * 128 + 8 * c8); }
    }
    const int irow = 16 * wave + r;
    bf16x8 xq[4];
    {
        const bf16* qp = P + (size_t)(row0 + irow) * NIN + h * 128 + 8 * q;
        float f[4][8];
#pragma unroll
        for (int ks = 0; ks < 4; ++ks) { const u32x4 rw = *(const u32x4*)(qp + 32 * ks);
            f[ks][0] = bf_lo(rw.x); f[ks][1] = bf_hi(rw.x); f[ks][2] = bf_lo(rw.y); f[ks][3] = bf_hi(rw.y); f[ks][4] = bf_lo(rw.z); f[ks][5] = bf_hi(rw.z); f[ks][6] = bf_lo(rw.w); f[ks][7] = bf_hi(rw.w); }
        const int n = pos0 + irow;
#pragma unroll
        for (int ks = 0; ks < 2; ++ks) { const float p = ks == 0 ? (float)(n >> 6) : (float)(n & 63);
#pragma unroll
            for (int i = 0; i < 8; ++i) { const int fi = 8 * q + i; const float fr = exp2f(-(float)fi * (13.287712379549449f / 32.0f)); float sn, cs; __sincosf(p * fr, &sn, &cs);
                const float t1 = f[ks][i], t2 = f[ks + 2][i]; f[ks][i] = t1 * cs - t2 * sn; f[ks + 2][i] = t1 * sn + t2 * cs; } }
#pragma unroll
        for (int ks = 0; ks < 4; ++ks) { u32x4 o; o.x = pk2(f[ks][0], f[ks][1]); o.y = pk2(f[ks][2], f[ks][3]); o.z = pk2(f[ks][4], f[ks][5]); o.w = pk2(f[ks][6], f[ks][7]); xq[ks] = __builtin_bit_cast(bf16x8, o); }
    }
    __syncthreads();
    f32x4 acc[8];
#pragma unroll
    for (int nt = 0; nt < 8; ++nt) acc[nt] = (f32x4){0.f, 0.f, 0.f, 0.f};
    strip_mma<false>(acc, xq, Ks, r, q);
    __syncthreads();
    LAS bf16* Ps = Ks;
#pragma unroll
    for (int nt = 0; nt < 8; ++nt) { float pv[4];
#pragma unroll
        for (int jj = 0; jj < 4; ++jj) { const int df = irow - (16 * nt + 4 * q + jj);
            const float m = df > 0 ? exp2f((float)df * lgf) : (df < 0 ? exp2f((float)(-df) * lgb) : 2.0f); pv[jj] = acc[nt][jj] * m; }
        u32x2 o; o.x = pk2(pv[0], pv[1]); o.y = pk2(pv[2], pv[3]); *(LAS u32x2*)(Ps + irow * TP + 16 * nt + 4 * q) = o; }
    const float xif = exp2f((float)(irow + 1) * lgf), xib = exp2f((float)(128 - irow) * lgb);
#pragma unroll
    for (int nt = 0; nt < 8; ++nt) acc[nt] = (f32x4){0.f, 0.f, 0.f, 0.f};
    strip_mma<false>(acc, xq, Sb, r, q);
    { const float rt = xib / xif;
#pragma unroll
      for (int nt = 0; nt < 8; ++nt) acc[nt] *= rt; }
    strip_mma<false>(acc, xq, Sf, r, q);
#pragma unroll
    for (int nt = 0; nt < 8; ++nt) acc[nt] *= xif;
    {
        bf16x8 xp[4];
#pragma unroll
        for (int ks = 0; ks < 4; ++ks) xp[ks] = frag_R(Ps, irow, ks, q);
        strip_mma<true>(acc, xp, Vt, r, q);
    }
    float ss = 0.f;
#pragma unroll
    for (int nt = 0; nt < 8; ++nt) ss += (acc[nt][0] * acc[nt][0] + acc[nt][1] * acc[nt][1]) + (acc[nt][2] * acc[nt][2] + acc[nt][3] * acc[nt][3]);
    ss += __shfl_xor(ss, 16); ss += __shfl_xor(ss, 32);
    const float rstd = 1.0f / sqrtf(ss * (1.0f / 128.0f) + EPS);
    const bf16* gp = P + (size_t)(row0 + irow) * NIN + 1536 + h * 128 + 4 * q;
    bf16* op = MIX + (size_t)(row0 + irow) * D + h * 128 + 4 * q;
#pragma unroll
    for (int nt = 0; nt < 8; ++nt) { const u32x2 gg = *(const u32x2*)(gp + 16 * nt);
        u32x2 o; o.x = pk2(acc[nt][0] * rstd * pg8::silu_f(bf_lo(gg.x)), acc[nt][1] * rstd * pg8::silu_f(bf_hi(gg.x)));
        o.y = pk2(acc[nt][2] * rstd * pg8::silu_f(bf_lo(gg.y)), acc[nt][3] * rstd * pg8::silu_f(bf_hi(gg.y)));
        *(u32x2*)(op + 16 * nt) = o; }
    __syncthreads();
}

#ifndef ONLY
#define ONLY (-1)
#endif
#define ON(p) (ONLY < 0 || ONLY == (p))
enum { PH_P0 = 0, PH_P1, PH_G1, PH_G2, PH_P2, PH_G3, PH_R1, PH_R2, PH_R3, PH_G4, PH_P3, PH_G5, PH_G6, PH_F, PH_N };

__global__ void __launch_bounds__(NTHR, 2) mk_fwd(Args a) {
    extern __shared__ __attribute__((aligned(16))) unsigned char lds_raw[];
    LAS unsigned char* lds = (LAS unsigned char*)lds_raw;
    cg::grid_group grid = cg::this_grid();
    volatile LAS unsigned* xbst = (volatile LAS unsigned*)(lds + LDS_BYTES - 16);
    if (threadIdx.x < 4) xbst[threadIdx.x] = 0u;
    __syncthreads();
    XcdBarrier xbar = xcd_barrier_post((unsigned*)(a.ws + WS_BAR), xbst);
    unsigned char* ws = a.ws;
    const float* mod = (const float*)(ws + WS_MOD);
    bf16* H = (bf16*)(ws + WS_H); bf16* ACT = (bf16*)(ws + WS_ACT); bf16* MIX = (bf16*)(ws + WS_MIX);
    float* X1C = (float*)(ws + WS_X1C);
    const int G = gridDim.x;
    for (int ph = a.ph_lo; ph < a.ph_hi; ++ph) {
        const int bx = lbid();
        switch (ph) {
        case PH_P0: if constexpr (ON(PH_P0)) phase_p0(a, lds); break;
        case PH_P1: if constexpr (ON(PH_P1)) phase_normmod(a.in[0], a.in[2], MT, a.in[6], mod, 0, H); break;
        case PH_P2: if constexpr (ON(PH_P1)) phase_normmod(a.out, X1C, MT, a.in[6] + D, mod, 3, H); break;
        case PH_P3: if constexpr (ON(PH_P1)) phase_normmod(a.out, X1C, MX, a.in[6] + 2 * D, mod, 6, H); break;
        case PH_G1: case PH_G5: if constexpr (ON(PH_G1)) {
            const int M = ph == PH_G1 ? MT : MX;
            pg8::Gemm g{H, (const bf16*)(ws + (ph == PH_G1 ? WS_W1A : WS_W1B)), M, 2 * FF, D}; pg8::StaticOrder S; S.init(M, 2 * FF, G, bx);
            pg8::EpiSwiglu E{ACT, FF};
            pg8::gemm_phase<pg8::EpiSwiglu, pg8::StaticOrder, true, true>(lds, g, S, E);
        } break;
        case PH_G2: case PH_G4: case PH_G6: if constexpr (ON(PH_G2)) {
            pg8::Gemm g; pg8::EpiResid E;
            if (ph == PH_G2)      { g = pg8::Gemm{ACT, (const bf16*)(ws + WS_W2A), MT, D, FF}; E = pg8::EpiResid{a.in[0], a.in[2], a.out, X1C, mod, 2, 0.5f}; }
            else if (ph == PH_G4) { g = pg8::Gemm{MIX, (const bf16*)(ws + WS_WOUT), MX, D, D}; E = pg8::EpiResid{a.out, X1C, a.out, X1C, mod, 5, 1.0f}; }
            else                  { g = pg8::Gemm{ACT, (const bf16*)(ws + WS_W2B), MX, D, FF}; E = pg8::EpiResid{a.out, X1C, a.out, X1C, mod, 8, 0.5f}; }
            pg8::StaticOrder S; S.init(g.M, g.N, G, bx);
            pg8::gemm_phase<pg8::EpiResid, pg8::StaticOrder, true, true>(lds, g, S, E);
        } break;
        case PH_G3: if constexpr (ON(PH_G3)) {
            pg8::Gemm g{H, (const bf16*)(ws + WS_WIN), MT, NIN, D}; pg8::StaticOrder S; S.init(MT, NIN, G, bx);
            pg8::EpiPlainBf16 E{ACT, NIN};
            pg8::gemm_phase<pg8::EpiPlainBf16, pg8::StaticOrder, true, true>(lds, g, S, E);
        } break;
        case PH_R1: if constexpr (ON(PH_R1)) phase_r1(a, lds); break;
        case PH_R2: if constexpr (ON(PH_R2)) phase_r2(a); break;
        case PH_R3: if constexpr (ON(PH_R3)) for (int it = bx; it < 512; it += G) r3_item(a, lds, it); break;
        case PH_F: if constexpr (ON(PH_F)) phase_final(a.out, a.in[16]); break;
        default: break;
        }
        if (ph + 1 < a.ph_hi) {
            if (ph == PH_P0) {
                asm volatile("s_waitcnt vmcnt(0) lgkmcnt(0)" ::: "memory");
                __syncthreads();
                if (ltid() < 64) asm volatile("buffer_wbl2 sc1\n\ts_waitcnt vmcnt(0)" ::: "memory");
                grid.sync();
                asm volatile("buffer_inv sc1\n\ts_waitcnt vmcnt(0)" ::: "memory");
            } else xcd_barrier(xbar);
        }
    }
}

extern "C" void kernel_launch(void* const* d_in, const int* in_sizes, int n_in, void* d_out, int out_size, void* d_ws, size_t ws_size, hipStream_t stream) {
    static int grid = 0;
    if (grid == 0) {
        if (n_in != 17 || out_size != MX * D || ws_size < WS_END) { fprintf(stderr, "kernel_launch: unexpected shapes (n_in %d out %d ws %zu)\n", n_in, out_size, ws_size); grid = -1; return; }
        int dev = 0, cus = 0, per_cu = 0;
        hipGetDevice(&dev); hipDeviceGetAttribute(&cus, hipDeviceAttributeMultiprocessorCount, dev);
        if (hipFuncSetAttribute((const void*)mk_fwd, hipFuncAttributeMaxDynamicSharedMemorySize, LDS_BYTES) != hipSuccess) { fprintf(stderr, "kernel_launch: hipFuncSetAttribute failed\n"); grid = -1; return; }
        if (hipOccupancyMaxActiveBlocksPerMultiprocessor(&per_cu, (const void*)mk_fwd, NTHR, LDS_BYTES) != hipSuccess || per_cu < 1) { fprintf(stderr, "kernel_launch: occupancy query failed (%d)\n", per_cu); (void)hipGetLastError(); per_cu = 1; }
        grid = cus * per_cu;
        fprintf(stderr, "kernel_launch: %d CUs x %d = grid %d\n", cus, per_cu, grid);
    }
    if (grid < 0) return;
    if (hipMemsetAsync((char*)d_ws + WS_BAR, 0, XCD_BAR_WORDS * 4, stream) != hipSuccess) { fprintf(stderr, "kernel_launch: memset failed\n"); return; }
    Args a{};
    for (int i = 0; i < 17; ++i) a.in[i] = (const float*)d_in[i];
    a.out = (float*)d_out; a.ws = (unsigned char*)d_ws; a.ph_lo = 0; a.ph_hi = PH_N;
#ifndef N_LAUNCH_PER_PHASE
    void* args[] = {&a};
    const hipError_t e = hipLaunchCooperativeKernel((const void*)mk_fwd, dim3(grid), dim3(NTHR), args, LDS_BYTES, stream);
    if (e != hipSuccess) fprintf(stderr, "kernel_launch: cooperative launch failed: %s (grid %d)\n", hipGetErrorString(e), grid);
#else
    for (int p = 0; p < PH_N; ++p) { if (!((PHASE_MASK >> p) & 1)) continue; a.ph_lo = p; a.ph_hi = p + 1; hipLaunchKernelGGL(mk_fwd, dim3(grid), dim3(NTHR), LDS_BYTES, stream, a); }
#endif
}
```

```cpp
#include <hip/hip_runtime.h>
#include <hip/hip_cooperative_groups.h>
#include <cstdio>
#include <cstdint>
namespace cg = cooperative_groups;
__device__ __forceinline__ int ltid() { int t = threadIdx.x; asm volatile("" : "+v"(t)); return t; }
__device__ __forceinline__ int lbid() { int t = blockIdx.x; asm volatile("" : "+s"(t)); return t; }
typedef float f32x2_t __attribute__((ext_vector_type(2))); typedef __bf16 bf16x2_t __attribute__((ext_vector_type(2)));
__device__ __forceinline__ unsigned cvtpk(float lo, float hi) { f32x2_t v = {lo, hi}; bf16x2_t b = __builtin_convertvector(v, bf16x2_t); return __builtin_bit_cast(unsigned, b); }
namespace pg8 {
#define PG8_LAS __attribute__((address_space(3)))
typedef unsigned short bf16_t;
typedef short bf16x8 __attribute__((ext_vector_type(8)));
typedef float f32x4 __attribute__((ext_vector_type(4)));
typedef unsigned u32x4 __attribute__((ext_vector_type(4)));
constexpr int BM = 256, BK = 64, HALF = 128, HTB = HALF * BK * 2  , STAGE_BYTES = 8 * HTB, NXCD = 8, WGM = 8;

__host__ __device__ __forceinline__ int lds_byte(int r, int c) { const int st = (r >> 4) * 2 + (c >> 5), rr = r & 15, cc = c & 31, ob = rr * 64 + cc * 2; return st * 1024 + (ob ^ (((ob >> 9) & 1) << 5)); }
__host__ __device__ __forceinline__ void stage_rc(int b, int& R, int& C) { const int st = b / 1024, sb = b % 1024, swz = sb ^ (((sb >> 9) & 1) << 5); R = (st >> 1) * 16 + swz / 64; C = (st & 1) * 32 + (swz % 64) / 2; }
__host__ __device__ __forceinline__ int perm32(int rho) { const int n = rho >> 4, i = rho & 15; return 8 * (i >> 2) + 4 * n + (i & 3); }

struct Unit { int pm, pn; };
struct Gemm { const bf16_t* A; const bf16_t* Bt; int M, N, K; };

struct StaticOrder {
    int nM, nN, nwg, G, c;
    __host__ __device__ void init(int M, int N, int G_, int c_) { nM = M / BM; nN = N / BM; nwg = nM * nN; G = G_; c = c_; }
    __host__ __device__ bool next(int i, Unit& u) const {
        const long L = (long)i * G + c; if (L >= nwg) return false;
        int wgid = (int)L; { const int q = nwg / NXCD, r = nwg % NXCD, xcd = wgid % NXCD, off = wgid / NXCD; wgid = (xcd < r ? xcd * (q + 1) : r * (q + 1) + (xcd - r) * q) + off; }
        const int nig = WGM * nN, gid = wgid / nig, fm = gid * WGM, gsz = (nM - fm) < WGM ? (nM - fm) : WGM;
        u.pm = fm + ((wgid % nig) % gsz); u.pn = (wgid % nig) / gsz; return true;
    }
    __device__ __forceinline__ void a_ready(const Unit&) const {}
    __device__ __forceinline__ void done(const Unit&) const {}
};

__device__ __forceinline__ unsigned cvt_pk_bf16(float lo, float hi) { unsigned r; asm volatile("v_cvt_pk_bf16_f32 %0, %1, %2" : "=v"(r) : "v"(lo), "v"(hi)); return r; }
typedef float f32x2 __attribute__((ext_vector_type(2)));

__device__ __forceinline__ float silu_f(float x) { return x * __builtin_amdgcn_rcpf(1.0f + __expf(-x)); }

struct EpiSwiglu {
    static constexpr bool PERM = true, AFTER_DRAIN = false;
    bf16_t* O; int ldc;
    __device__ __forceinline__ void operator()(const f32x4 (&acc)[2][2][4][2], const Unit& u, int wr, int wc, int fr, int fq) const {
        const int row0 = u.pm * BM + wr * 64 + fr, col0 = u.pn * HALF + wc * 32 + 8 * fq;
#pragma unroll
        for (int ai = 0; ai < 2; ++ai)
#pragma unroll
            for (int m = 0; m < 4; ++m) {
                bf16_t* rowp = O + (size_t)(row0 + ai * HALF + m * 16) * ldc + col0;
                const f32x4 g0 = acc[ai][0][m][0], g1 = acc[ai][0][m][1], u0 = acc[ai][1][m][0], u1 = acc[ai][1][m][1];
                u32x4 w;
                w.x = ::cvtpk(silu_f(g0[0]) * u0[0], silu_f(g0[1]) * u0[1]); w.y = ::cvtpk(silu_f(g0[2]) * u0[2], silu_f(g0[3]) * u0[3]);
                w.z = ::cvtpk(silu_f(g1[0]) * u1[0], silu_f(g1[1]) * u1[1]); w.w = ::cvtpk(silu_f(g1[2]) * u1[2], silu_f(g1[3]) * u1[3]);
                *(u32x4*)rowp = w;
            }
    }
};
struct EpiPlainBf16 {
    static constexpr bool PERM = true, AFTER_DRAIN = false;
    bf16_t* O; int ldc;
    __device__ __forceinline__ void operator()(const f32x4 (&acc)[2][2][4][2], const Unit& u, int wr, int wc, int fr, int fq) const {
        const int row0 = u.pm * BM + wr * 64 + fr, col0 = u.pn * BM + wc * 32 + 8 * fq;
#pragma unroll
        for (int ai = 0; ai < 2; ++ai)
#pragma unroll
            for (int m = 0; m < 4; ++m) {
                bf16_t* rowp = O + (size_t)(row0 + ai * HALF + m * 16) * ldc + col0;
#pragma unroll
                for (int bj = 0; bj < 2; ++bj) {
                    const f32x4 v0 = acc[ai][bj][m][0], v1 = acc[ai][bj][m][1];
                    u32x4 w; w.x = ::cvtpk(v0[0], v0[1]); w.y = ::cvtpk(v0[2], v0[3]); w.z = ::cvtpk(v1[0], v1[1]); w.w = ::cvtpk(v1[2], v1[3]);
                    *(u32x4*)(rowp + bj * HALF) = w;
                }
            }
    }
};
struct EpiResid {
    static constexpr bool PERM = false, AFTER_DRAIN = false;
    const float* xin_lat; const float* xin_ctx; float* out_lat; float* out_ctx; const float* mod; int slot; float coef;
    __device__ __forceinline__ void operator()(const f32x4 (&acc)[2][2][4][2], const Unit& u, int wr, int wc, int fr, int fq) const {
        const bool isctx = u.pm >= 64; const int mb = isctx ? 4 : (u.pm >> 4);
        const float* xin = isctx ? xin_ctx : xin_lat; float* out = isctx ? out_ctx : out_lat;
        const int row0 = (isctx ? u.pm - 64 : u.pm) * BM + wr * 64 + fr, col0 = u.pn * BM + wc * 32 + 4 * fq;
        const float* mrow = mod + mb * 9216 + slot * 1024 + col0;
        f32x4 gv[2][2];
#pragma unroll
        for (int bj = 0; bj < 2; ++bj)
#pragma unroll
            for (int n = 0; n < 2; ++n) gv[bj][n] = *(const f32x4*)(mrow + bj * HALF + n * 16) * coef;
#pragma unroll
        for (int ai = 0; ai < 2; ++ai)
#pragma unroll
            for (int m = 0; m < 4; ++m) { const size_t off = (size_t)(row0 + ai * HALF + m * 16) * 1024 + col0;
#pragma unroll
                for (int bj = 0; bj < 2; ++bj)
#pragma unroll
                    for (int n = 0; n < 2; ++n) { const f32x4 xi = *(const f32x4*)(xin + off + bj * HALF + n * 16);
                        *(f32x4*)(out + off + bj * HALF + n * 16) = xi + gv[bj][n] * acc[ai][bj][m][n]; } }
    }
};

template <class Epi, class Sched, bool ALIGN_EPI = false, bool SP2 = false>
__device__ __forceinline__ void gemm_phase(PG8_LAS unsigned char* lds, const Gemm g, const Sched& S, const Epi& E) {
    const int tid = ltid(), wid = __builtin_amdgcn_readfirstlane(tid >> 6), lane = tid & 63, wr = wid >> 2, wc = wid & 3, fr = lane & 15, fq = lane >> 4;
    const int K = g.K, nt = K / BK;
    unsigned voffA[2], voffB[2];
#pragma unroll
    for (int i = 0; i < 2; ++i) { int R, C; stage_rc(tid * 16 + i * 8192, R, C); const int Rb = Epi::PERM ? ((R & ~31) + perm32(R & 31)) : R;
        voffA[i] = (unsigned)(R * K + C) * 2u; voffB[i] = (unsigned)(Rb * K + C) * 2u; }
    const size_t kstep = (size_t)(BK * 2);
    const size_t hstep = (size_t)HALF * K * 2;
    const size_t tstep = 2 * hstep;
    const unsigned ldsw = (unsigned)wid * 1024u;
    const int aoff = lds_byte(wr * 64 + fr, fq * 8), boff = lds_byte(wc * 32 + fr, fq * 8);
#define PG8_SA(b, h) (((b) * 2 + (h)) * HTB)
#define PG8_SB(b, h) ((4 + (b) * 2 + (h)) * HTB)
#define PG8_STAGE(bufoff, gbase, voff) do { _Pragma("unroll") for (int _i = 0; _i < 2; ++_i) \
        __builtin_amdgcn_global_load_lds((const unsigned*)((const char*)(gbase) + (voff)[_i]), (PG8_LAS unsigned*)(lds + (bufoff) + ldsw + _i * 8192), 16, 0, 0); } while (0)
#define PG8_LDA(dst, b, h) do { _Pragma("unroll") for (int m = 0; m < 4; ++m) _Pragma("unroll") for (int k = 0; k < 2; ++k) dst[m][k] = *(const PG8_LAS bf16x8*)(lds + PG8_SA(b, h) + aoff + m * 2048 + k * 1024); } while (0)
#define PG8_LDB(dst, b, h) do { _Pragma("unroll") for (int n = 0; n < 2; ++n) _Pragma("unroll") for (int k = 0; k < 2; ++k) dst[n][k] = *(const PG8_LAS bf16x8*)(lds + PG8_SB(b, h) + boff + n * 2048 + k * 1024); } while (0)
#define PG8_MMA(ai, bj, At, Bt) do { __builtin_amdgcn_s_setprio(1); _Pragma("unroll") for (int m = 0; m < 4; ++m) _Pragma("unroll") for (int n = 0; n < 2; ++n) _Pragma("unroll") for (int k = 0; k < 2; ++k) \
        acc[ai][bj][m][n] = __builtin_amdgcn_mfma_f32_16x16x32_bf16(Bt[n][k], At[m][k], acc[ai][bj][m][n], 0, 0, 0); __builtin_amdgcn_s_setprio(0); } while (0)
#define PG8_WAIT_V(n) asm volatile("s_waitcnt vmcnt(" #n ")" ::: "memory")
#define PG8_WAIT_L(n) asm volatile("s_waitcnt lgkmcnt(" #n ")" ::: "memory")
#define PG8_BAR __builtin_amdgcn_s_barrier()
#define PG8_SCHED __builtin_amdgcn_sched_barrier(0)
    Unit cur, nxt; int ui = 0;
    if (!S.next(0, cur)) return;
    f32x4 acc[2][2][4][2];
#pragma unroll
    for (int a = 0; a < 2; ++a)
#pragma unroll
        for (int b = 0; b < 2; ++b)
#pragma unroll
            for (int m = 0; m < 4; ++m)
#pragma unroll
                for (int n = 0; n < 2; ++n) acc[a][b][m][n] = (f32x4){0.f, 0.f, 0.f, 0.f};
    bf16x8 At[4][2], B0[2][2], B1[2][2];
    const char* cA = (const char*)g.A + (size_t)cur.pm * tstep; const char* cB = (const char*)g.Bt + (size_t)cur.pn * tstep;
    S.a_ready(cur);
    if constexpr (SP2) {
        PG8_STAGE(PG8_SB(0, 0), cB, voffB); PG8_STAGE(PG8_SB(0, 1), cB + hstep, voffB); PG8_STAGE(PG8_SA(0, 0), cA, voffA); PG8_STAGE(PG8_SA(0, 1), cA + hstep, voffA);
        if (wr == 1) PG8_BAR;
        PG8_WAIT_V(2); PG8_BAR;
        PG8_STAGE(PG8_SB(1, 0), cB + kstep, voffB); PG8_STAGE(PG8_SA(1, 0), cA + kstep, voffA); PG8_STAGE(PG8_SB(1, 1), cB + hstep + kstep, voffB);
        PG8_WAIT_V(6); PG8_BAR;
    } else {
        PG8_STAGE(PG8_SB(0, 0), cB, voffB); PG8_STAGE(PG8_SA(0, 0), cA, voffA); PG8_STAGE(PG8_SB(0, 1), cB + hstep, voffB); PG8_STAGE(PG8_SA(0, 1), cA + hstep, voffA);
        if (wr == 1) PG8_BAR;
        PG8_WAIT_V(4); PG8_BAR;
        PG8_STAGE(PG8_SB(1, 0), cB + kstep, voffB); PG8_STAGE(PG8_SA(1, 0), cA + kstep, voffA); PG8_STAGE(PG8_SB(1, 1), cB + hstep + kstep, voffB);
        PG8_WAIT_V(6); PG8_BAR;
    }
    for (;;) {
        const bool has_next = S.next(ui + 1, nxt);
        const char* nA = has_next ? (const char*)g.A + (size_t)nxt.pm * tstep : cA; const char* nB = has_next ? (const char*)g.Bt + (size_t)nxt.pn * tstep : cB;
        for (int t = 0; t < nt; t += 2) {
            const bool last = (t == nt - 2);
            const char* a1 = cA + (size_t)(t + 1) * kstep;
            const char* a2 = last ? nA : cA + (size_t)(t + 2) * kstep; const char* b2 = last ? nB : cB + (size_t)(t + 2) * kstep;
            const char* a3 = a2 + kstep; const char* b3 = b2 + kstep;
            if (last && has_next) S.a_ready(nxt);
            if constexpr (SP2) {
            PG8_LDB(B0, 0, 0); PG8_LDB(B1, 0, 1); PG8_SCHED; PG8_LDA(At, 0, 0); PG8_STAGE(PG8_SA(1, 1), a1 + hstep, voffA);
            PG8_WAIT_V(8); PG8_WAIT_L(0); PG8_BAR; PG8_MMA(0, 0, At, B0); PG8_MMA(0, 1, At, B1); PG8_BAR; PG8_SCHED;
            PG8_LDA(At, 0, 1); PG8_STAGE(PG8_SB(0, 0), b2, voffB); PG8_STAGE(PG8_SB(0, 1), b2 + hstep, voffB); PG8_STAGE(PG8_SA(0, 0), a2, voffA);
            PG8_WAIT_V(8); PG8_WAIT_L(0); PG8_BAR; PG8_MMA(1, 0, At, B0); PG8_MMA(1, 1, At, B1); PG8_BAR; PG8_SCHED;
            PG8_LDB(B0, 1, 0); PG8_LDB(B1, 1, 1); PG8_SCHED; PG8_LDA(At, 1, 0); PG8_STAGE(PG8_SA(0, 1), a2 + hstep, voffA);
            PG8_WAIT_V(8); PG8_WAIT_L(0); PG8_BAR; PG8_MMA(0, 0, At, B0); PG8_MMA(0, 1, At, B1); PG8_BAR; PG8_SCHED;
            PG8_LDA(At, 1, 1); PG8_STAGE(PG8_SB(1, 0), b3, voffB); PG8_STAGE(PG8_SB(1, 1), b3 + hstep, voffB); PG8_STAGE(PG8_SA(1, 0), a3, voffA);
            PG8_WAIT_V(8); PG8_WAIT_L(0); PG8_BAR; PG8_MMA(1, 0, At, B0); PG8_MMA(1, 1, At, B1); PG8_BAR; PG8_SCHED;
            } else {
            PG8_LDB(B0, 0, 0); PG8_SCHED; PG8_LDA(At, 0, 0); PG8_STAGE(PG8_SA(1, 1), a1 + hstep, voffA);
            PG8_WAIT_L(8); PG8_BAR; PG8_WAIT_L(0); PG8_MMA(0, 0, At, B0); PG8_BAR; PG8_SCHED;
            PG8_LDB(B1, 0, 1); PG8_STAGE(PG8_SB(0, 0), b2, voffB);
            PG8_BAR; PG8_WAIT_L(0); PG8_MMA(0, 1, At, B1); PG8_BAR;
            PG8_LDA(At, 0, 1); PG8_STAGE(PG8_SA(0, 0), a2, voffA);
            PG8_BAR; PG8_WAIT_L(0); PG8_MMA(1, 0, At, B0); PG8_BAR; PG8_SCHED;
            PG8_STAGE(PG8_SB(0, 1), b2 + hstep, voffB);
            PG8_WAIT_V(6); PG8_BAR; PG8_MMA(1, 1, At, B1); PG8_BAR;
            PG8_LDB(B0, 1, 0); PG8_SCHED; PG8_LDA(At, 1, 0); PG8_STAGE(PG8_SA(0, 1), a2 + hstep, voffA);
            PG8_WAIT_L(8); PG8_BAR; PG8_WAIT_L(0); PG8_MMA(0, 0, At, B0); PG8_BAR; PG8_SCHED;
            PG8_LDB(B1, 1, 1); PG8_STAGE(PG8_SB(1, 0), b3, voffB);
            PG8_BAR; PG8_WAIT_L(0); PG8_MMA(0, 1, At, B1); PG8_BAR;
            PG8_LDA(At, 1, 1); PG8_STAGE(PG8_SA(1, 0), a3, voffA);
            PG8_BAR; PG8_WAIT_L(0); PG8_MMA(1, 0, At, B0); PG8_BAR; PG8_SCHED;
            PG8_STAGE(PG8_SB(1, 1), b3 + hstep, voffB);
            PG8_WAIT_V(6); PG8_BAR; PG8_MMA(1, 1, At, B1); PG8_BAR;
            }
        }
        if constexpr (ALIGN_EPI) { if (wr == 0) PG8_BAR; }
        if constexpr (!Epi::AFTER_DRAIN) { E(acc, cur, wr, wc, fr, fq); S.done(cur); }
        if (!has_next) break;
#pragma unroll
        for (int a = 0; a < 2; ++a)
#pragma unroll
            for (int b = 0; b < 2; ++b)
#pragma unroll
                for (int m = 0; m < 4; ++m)
#pragma unroll
                    for (int n = 0; n < 2; ++n) acc[a][b][m][n] = (f32x4){0.f, 0.f, 0.f, 0.f};
        cur = nxt; cA = nA; cB = nB; ++ui;
        if constexpr (ALIGN_EPI) { if (wr == 1) PG8_BAR; }
    }
    PG8_WAIT_V(0);
    if constexpr (!ALIGN_EPI) { if (wr == 0) PG8_BAR; }
    PG8_BAR;
    if constexpr (Epi::AFTER_DRAIN) { E.fused(acc, cur, wr, wc, fr, fq, lds, wid, lane); S.done(cur); }
#undef PG8_SA
#undef PG8_SB
#undef PG8_STAGE
#undef PG8_LDA
#undef PG8_LDB
#undef PG8_MMA
#undef PG8_WAIT_V
#undef PG8_WAIT_L
#undef PG8_BAR
#undef PG8_SCHED
}
}
#define XB_TMO      128
#define XB_XCNT(j)  (256  + 64 * (j))
#define XB_XSUB(j)  (1280 + 64 * (j))
#define XB_XGEN(j)  (2304 + 64 * (j))
#define XB_TOP      3328
#define XB_TOPGEN   3392
#define XCD_BAR_WORDS 3456
#define XB_SPIN_CAP (1u << 18)
#define LAS __attribute__((address_space(3)))

__device__ __forceinline__ unsigned xb_ld(unsigned* p)              { return __hip_atomic_load(p, __ATOMIC_RELAXED, __HIP_MEMORY_SCOPE_AGENT); }
__device__ __forceinline__ unsigned xb_add(unsigned* p, unsigned v) { return __hip_atomic_fetch_add(p, v, __ATOMIC_RELAXED, __HIP_MEMORY_SCOPE_AGENT); }
__device__ __forceinline__ unsigned xb_xcc_id() { return (unsigned)__builtin_amdgcn_s_getreg((3 << 11) | 20) & 0xFu; }
#define XB_SPIN(cond, bar) do { unsigned _sp = 0; while (cond) { __builtin_amdgcn_s_sleep(1); \
    if ((++_sp & 255u) == 0u) { if (xb_ld(&(bar)[XB_TMO])) break; if (_sp > XB_SPIN_CAP) { atomicAdd(&(bar)[XB_TMO], 1u); break; } } } } while (0)

struct XcdBarrier {
    unsigned* bar; unsigned x;
    volatile LAS unsigned* st;
};

__device__ __forceinline__ XcdBarrier xcd_barrier_post(unsigned* bar, volatile LAS unsigned* st) {
    XcdBarrier b; b.bar = bar; b.x = xb_xcc_id(); b.st = st;
    if (threadIdx.x == 0) (void)xb_add(&bar[XB_XCNT(b.x)], 1u);
    return b;
}
__device__ __forceinline__ void xcd_barrier_complete(unsigned* bar, unsigned x, unsigned& nloc, unsigned& nx) {
    const unsigned G = gridDim.x * gridDim.y * gridDim.z;
    unsigned sum, cnt, mine, sp = 0u;
    for (;;) {
        sum = 0u; cnt = 0u; mine = 0u;
#pragma unroll
        for (unsigned j = 0; j < 16; ++j) { const unsigned c = xb_ld(&bar[XB_XCNT(j)]); sum += c; cnt += (c > 0u) ? 1u : 0u; mine = (j == x) ? c : mine; }
        if (sum == G) break;
        __builtin_amdgcn_s_sleep(1);
        if ((++sp & 255u) == 0u) { if (xb_ld(&bar[XB_TMO])) break; if (sp > XB_SPIN_CAP) { atomicAdd(&bar[XB_TMO], 1u); break; } }
    }
    nloc = mine > 0u ? mine : 1u; nx = cnt > 0u ? cnt : 1u;
}

__device__ __forceinline__ void xcd_barrier(const XcdBarrier& b) {
    asm volatile("s_waitcnt vmcnt(0)" ::: "memory");
    __syncthreads();
    if (threadIdx.x == 0) {
        unsigned* bar = b.bar;
        __builtin_amdgcn_s_waitcnt(0);
        unsigned nloc = b.st[0], nx = b.st[1];
        if (nloc == 0u) { xcd_barrier_complete(bar, b.x, nloc, nx); b.st[0] = nloc; b.st[1] = nx; }
        const unsigned old = xb_add(&bar[XB_XSUB(b.x)], 1u);
        const unsigned gen = old / nloc;
        if (old + 1u == (gen + 1u) * nloc) {
            __builtin_amdgcn_fence(__ATOMIC_RELEASE, "agent");
            asm volatile("s_waitcnt vmcnt(0)" ::: "memory");
            const unsigned og = xb_add(&bar[XB_TOP], 1u);
            const unsigned tg = og / nx;
            if (og + 1u == (tg + 1u) * nx) xb_add(&bar[XB_TOPGEN], 1u);
            else XB_SPIN(xb_ld(&bar[XB_TOPGEN]) == tg, bar);
            __builtin_amdgcn_fence(__ATOMIC_ACQUIRE, "agent");
            xb_add(&bar[XB_XGEN(b.x)], 1u);
            asm volatile("s_waitcnt vmcnt(0)" ::: "memory");
        } else {
            XB_SPIN(xb_ld(&bar[XB_XGEN(b.x)]) == gen, bar);
            __builtin_amdgcn_fence(__ATOMIC_ACQUIRE, "agent");
            asm volatile("s_waitcnt vmcnt(0)" ::: "memory");
        }
    }
    __syncthreads();
}

#define LAS __attribute__((address_space(3)))
typedef unsigned short bf16;
typedef float f32x4 __attribute__((ext_vector_type(4)));
typedef short bf16x8 __attribute__((ext_vector_type(8)));
typedef unsigned u32x4 __attribute__((ext_vector_type(4)));
typedef unsigned u32x2 __attribute__((ext_vector_type(2)));

constexpr int D = 1024, NB = 4, SEQ = 4096, CTXL = 256, MX = NB * SEQ, MC = NB * CTXL, MT = MX + MC;
constexpr int FF = 2816, NIN = 3072, NMODC = 9 * D;
constexpr int CH = 128, NCH = SEQ / CH, NHEAD = 4;
constexpr float EPS = 1e-6f;
constexpr int NTHR = 512, NWAVES = 8;
constexpr int LDS_BYTES = 147456;
constexpr int TP = 136;
constexpr int TILE_B = 128 * TP * 2;
static_assert(4 * TILE_B <= LDS_BYTES, "lds");

constexpr size_t MiB = 1u << 20;
constexpr size_t WS_MOD = 0;
constexpr size_t WS_BAR = 512 * 1024;
constexpr size_t WS_W1A = 1 * MiB, WS_W2A = 12 * MiB, WS_WIN = 18 * MiB, WS_WOUT = 24 * MiB, WS_W1B = 26 * MiB, WS_W2B = 37 * MiB;
constexpr size_t WS_X1C = 43 * MiB;
constexpr size_t WS_H = 47 * MiB;
constexpr size_t WS_MIX = 81 * MiB;
constexpr size_t WS_ACT = 113 * MiB;
constexpr size_t WS_END = 215 * MiB;

struct Args { const float* in[17]; float* out; unsigned char* ws; int ph_lo, ph_hi; };

__device__ __forceinline__ unsigned pk2(float lo, float hi) { return cvtpk(lo, hi); }
__device__ __forceinline__ float bf_lo(unsigned w) { return __uint_as_float(w << 16); }
__device__ __forceinline__ float bf_hi(unsigned w) { return __uint_as_float(w & 0xffff0000u); }
__device__ __forceinline__ float wave_sum(float v) {
#pragma unroll
    for (int o = 1; o < 64; o <<= 1) v += __shfl_xor(v, o);
    return v;
}
__device__ __forceinline__ float gelu_tanh(float x) {
    const float z = 0.7978845608028654f * (x + 0.044715f * x * x * x);
    const float e = __expf(2.0f * z);
    const float t = 1.0f - 2.0f * __builtin_amdgcn_rcpf(1.0f + e);
    return 0.5f * x * (1.0f + t);
}

__device__ __forceinline__ void transpose_item(const float* W, int N, int K, bf16* WT, int k0, int n0, int drow0, LAS float* scr, int lane) {
    const int kq = lane >> 3, n4 = (lane & 7) * 4;
    f32x4 v[8];
#pragma unroll
    for (int i = 0; i < 8; ++i) v[i] = *(const f32x4*)(W + (size_t)(k0 + kq + 8 * i) * N + n0 + n4);
#pragma unroll
    for (int i = 0; i < 8; ++i) { LAS float* d = scr + (kq + 8 * i) * 33 + n4; d[0] = v[i].x; d[1] = v[i].y; d[2] = v[i].z; d[3] = v[i].w; }
    asm volatile("s_waitcnt lgkmcnt(0)" ::: "memory");
    const int c = lane & 7;
#pragma unroll
    for (int j = 0; j < 4; ++j) { const int n = (lane >> 3) + 8 * j; const LAS float* s = scr + (8 * c) * 33 + n;
        u32x4 o; o.x = pk2(s[0 * 33], s[1 * 33]); o.y = pk2(s[2 * 33], s[3 * 33]); o.z = pk2(s[4 * 33], s[5 * 33]); o.w = pk2(s[6 * 33], s[7 * 33]);
        *(u32x4*)(WT + (size_t)(drow0 + n) * K + k0 + 8 * c) = o; }
    asm volatile("s_waitcnt lgkmcnt(0)" ::: "memory");
}
__device__ __forceinline__ int w1_drow(int n0) { return n0 < FF ? (n0 >> 7) * 256 + (n0 & 127) : ((n0 - FF) >> 7) * 256 + 128 + ((n0 - FF) & 127); }

__device__ __forceinline__ void phase_p0(const Args& a, LAS unsigned char* lds) {
    const int tid = ltid(), lane = tid & 63, wave = tid >> 6;
    unsigned char* ws = a.ws;
    if (lbid() < 144 || gridDim.x < 144) {
        for (int cg0 = lbid(); cg0 < 144; cg0 += gridDim.x) {
            LAS float* sil = (LAS float*)lds;
            LAS float* red = (LAS float*)(lds + 20480);
            for (int i = tid; i < 5 * 1024; i += NTHR) { const int r = i >> 10, k = i & 1023; const float v = r < 4 ? a.in[1][r * 1024 + k] : a.in[3][k]; sil[i] = pg8::silu_f(v); }
            __syncthreads();
            const int cl = tid & 15, ks = tid >> 4, j0 = cg0 * 64 + 4 * cl;
            const float* wa = a.in[4] + (size_t)(ks * 32) * NMODC + j0;
            f32x4 acc[5];
#pragma unroll
            for (int r = 0; r < 5; ++r) acc[r] = (f32x4){0.f, 0.f, 0.f, 0.f};
#pragma unroll 8
            for (int k = 0; k < 32; ++k) { const f32x4 w = *(const f32x4*)(wa + (size_t)k * NMODC);
#pragma unroll
                for (int r = 0; r < 5; ++r) acc[r] += w * sil[r * 1024 + ks * 32 + k]; }
#pragma unroll
            for (int r = 0; r < 5; ++r) *(LAS f32x4*)(red + (ks * 5 + r) * 64 + 4 * cl) = acc[r];
            __syncthreads();
            if (tid < 320) { const int r = tid >> 6, col = tid & 63; float s = a.in[5][cg0 * 64 + col];
                for (int k = 0; k < 32; ++k) s += red[(k * 5 + r) * 64 + col];
                ((float*)(ws + WS_MOD))[r * NMODC + cg0 * 64 + col] = s; }
            __syncthreads();
        }
    }
    LAS float* scr = (LAS float*)(lds + wave * 16384);
    const int gw = lbid() * NWAVES + wave, NGW = gridDim.x * NWAVES;
    constexpr int I_W1 = (D / 64) * (2 * FF / 32), I_W2 = (FF / 64) * (D / 32), I_IN = (D / 64) * (NIN / 32), I_OUT = (D / 64) * (D / 32);
    constexpr int NITEMS = 2 * I_W1 + 2 * I_W2 + I_IN + I_OUT;
    for (int it = gw; it < NITEMS; it += NGW) {
        int r = it; const float* W; bf16* WT; int N, K; bool isw1 = false;
        if (r < I_W1) { W = a.in[7]; WT = (bf16*)(ws + WS_W1A); N = 2 * FF; K = D; isw1 = true; }
        else if ((r -= I_W1) < I_W2) { W = a.in[8]; WT = (bf16*)(ws + WS_W2A); N = D; K = FF; }
        else if ((r -= I_W2) < I_IN) { W = a.in[9]; WT = (bf16*)(ws + WS_WIN); N = NIN; K = D; }
        else if ((r -= I_IN) < I_OUT) { W = a.in[13]; WT = (bf16*)(ws + WS_WOUT); N = D; K = D; }
        else if ((r -= I_OUT) < I_W1) { W = a.in[14]; WT = (bf16*)(ws + WS_W1B); N = 2 * FF; K = D; isw1 = true; }
        else { r -= I_W1; W = a.in[15]; WT = (bf16*)(ws + WS_W2B); N = D; K = FF; }
        const int nblk = N / 32, kb = r / nblk, nb = r - kb * nblk, n0 = 32 * nb;
        transpose_item(W, N, K, WT, 64 * kb, n0, isw1 ? w1_drow(n0) : n0, scr, lane);
    }
}

__device__ __forceinline__ void phase_normmod(const float* xl, const float* xc, int nrows, const float* g, const float* mod, int shift_slot, bf16* H) {
    const int tid = ltid(), lane = tid & 63, gw = lbid() * NWAVES + (tid >> 6), NGW = gridDim.x * NWAVES;
    for (int rb = gw; rb < nrows; rb += 4 * NGW) {
        f32x4 v[4][4]; float ss[4];
#pragma unroll
        for (int k = 0; k < 4; ++k) { const int row = rb + k * NGW; ss[k] = 0.f;
            if (row < nrows) { const float* xr = row < MX ? xl + (size_t)row * D : xc + (size_t)(row - MX) * D;
#pragma unroll
                for (int j = 0; j < 4; ++j) v[k][j] = *(const f32x4*)(xr + 4 * lane + 256 * j); } }
#pragma unroll
        for (int k = 0; k < 4; ++k) { const int row = rb + k * NGW;
            if (row < nrows) {
#pragma unroll
                for (int j = 0; j < 4; ++j) ss[k] += (v[k][j].x * v[k][j].x + v[k][j].y * v[k][j].y) + (v[k][j].z * v[k][j].z + v[k][j].w * v[k][j].w);
                ss[k] = wave_sum(ss[k]); } }
#pragma unroll
        for (int k = 0; k < 4; ++k) { const int row = rb + k * NGW;
            if (row < nrows) {
                const float rstd = 1.0f / sqrtf(ss[k] * (1.0f / D) + EPS);
                const float* mrow = mod + (row < MX ? (row >> 12) : 4) * NMODC + shift_slot * D;
#pragma unroll
                for (int j = 0; j < 4; ++j) {
                    const f32x4 gv = *(const f32x4*)(g + 4 * lane + 256 * j);
                    const f32x4 sh = *(const f32x4*)(mrow + 4 * lane + 256 * j), sc = *(const f32x4*)(mrow + D + 4 * lane + 256 * j);
                    const f32x4 y = (v[k][j] * rstd) * gv * (sc + 1.0f) + sh;
                    u32x2 o; o.x = pk2(y.x, y.y); o.y = pk2(y.z, y.w);
                    *(u32x2*)(H + (size_t)row * D + 4 * lane + 256 * j) = o; } } }
    }
}
__device__ __forceinline__ void phase_final(float* xo, const float* g) {
    const int tid = ltid(), lane = tid & 63, gw = lbid() * NWAVES + (tid >> 6), NGW = gridDim.x * NWAVES;
    for (int rb = gw; rb < MX; rb += 4 * NGW) {
        f32x4 v[4][4]; float ss[4];
#pragma unroll
        for (int k = 0; k < 4; ++k) { const int row = rb + k * NGW; ss[k] = 0.f;
            if (row < MX) {
#pragma unroll
                for (int j = 0; j < 4; ++j) v[k][j] = *(const f32x4*)(xo + (size_t)row * D + 4 * lane + 256 * j); } }
#pragma unroll
        for (int k = 0; k < 4; ++k) { const int row = rb + k * NGW;
            if (row < MX) {
#pragma unroll
                for (int j = 0; j < 4; ++j) ss[k] += (v[k][j].x * v[k][j].x + v[k][j].y * v[k][j].y) + (v[k][j].z * v[k][j].z + v[k][j].w * v[k][j].w);
                ss[k] = wave_sum(ss[k]); } }
#pragma unroll
        for (int k = 0; k < 4; ++k) { const int row = rb + k * NGW;
            if (row < MX) { const float rstd = 1.0f / sqrtf(ss[k] * (1.0f / D) + EPS);
#pragma unroll
                for (int j = 0; j < 4; ++j) { const f32x4 gv = *(const f32x4*)(g + 4 * lane + 256 * j); *(f32x4*)(xo + (size_t)row * D + 4 * lane + 256 * j) = (v[k][j] * rstd) * gv; } } }
    }
}

__device__ __forceinline__ void tile_load(const bf16* base, int pitch, int tp, int dg, float (&v)[2][2][8]) {
#pragma unroll
    for (int tk = 0; tk < 2; ++tk)
#pragma unroll
        for (int h = 0; h < 2; ++h) { const u32x4 r = *(const u32x4*)(base + (size_t)(2 * tp + tk) * pitch + 64 * h + 8 * dg);
            v[tk][h][0] = bf_lo(r.x); v[tk][h][1] = bf_hi(r.x); v[tk][h][2] = bf_lo(r.y); v[tk][h][3] = bf_hi(r.y);
            v[tk][h][4] = bf_lo(r.z); v[tk][h][5] = bf_hi(r.z); v[tk][h][6] = bf_lo(r.w); v[tk][h][7] = bf_hi(r.w); }
}
__device__ __forceinline__ void tile_rope(float (&v)[2][2][8], int pos0, int dg) {
#pragma unroll
    for (int tk = 0; tk < 2; ++tk) { const int n = pos0 + tk; const float p = (dg < 4) ? (float)(n >> 6) : (float)(n & 63);
#pragma unroll
        for (int i = 0; i < 8; ++i) { const int fi = 8 * (dg & 3) + i; const float fr = exp2f(-(float)fi * (13.287712379549449f / 32.0f)); const float ang = p * fr;
            float sn, cs; __sincosf(ang, &sn, &cs);
            const float t1 = v[tk][0][i], t2 = v[tk][1][i]; v[tk][0][i] = t1 * cs - t2 * sn; v[tk][1][i] = t1 * sn + t2 * cs; } }
}
__device__ __forceinline__ void tile_write_T(LAS bf16* T, int tp, int dg, const float (&v)[2][2][8], float w0, float w1) {
#pragma unroll
    for (int h = 0; h < 2; ++h)
#pragma unroll
        for (int i = 0; i < 8; ++i) { const int d = 64 * h + 8 * dg + i; const int c = (tp >> 2) ^ ((d >> 3) & 7);
            ((LAS unsigned*)T)[d * (TP / 2) + c * 4 + (tp & 3)] = pk2(v[0][h][i] * w0, v[1][h][i] * w1); }
}
__device__ __forceinline__ void tile_write_R(LAS bf16* T, int tp, int dg, const float (&v)[2][2][8]) {
#pragma unroll
    for (int tk = 0; tk < 2; ++tk)
#pragma unroll
        for (int h = 0; h < 2; ++h) { u32x4 o; o.x = pk2(v[tk][h][0], v[tk][h][1]); o.y = pk2(v[tk][h][2], v[tk][h][3]); o.z = pk2(v[tk][h][4], v[tk][h][5]); o.w = pk2(v[tk][h][6], v[tk][h][7]);
            *(LAS u32x4*)(T + (2 * tp + tk) * TP + 64 * h + 8 * dg) = o; }
}
__device__ __forceinline__ bf16x8 frag_R(const LAS bf16* T, int row, int ks, int q) { return *(const LAS bf16x8*)(T + row * TP + 32 * ks + 8 * q); }
__device__ __forceinline__ bf16x8 frag_T(const LAS bf16* T, int row, int ks, int q) { return *(const LAS bf16x8*)(T + row * TP + (((4 * ks + q) ^ ((row >> 3) & 7)) << 3)); }
template <bool SWZ>
__device__ __forceinline__ void strip_mma(f32x4 (&acc)[8], const bf16x8 (&xa)[4], const LAS bf16* Y, int r, int q) {
#pragma unroll
    for (int ks = 0; ks < 4; ++ks)
#pragma unroll
        for (int nt = 0; nt < 8; ++nt) { const bf16x8 yb = SWZ ? frag_T(Y, 16 * nt + r, ks, q) : frag_R(Y, 16 * nt + r, ks, q);
            acc[nt] = __builtin_amdgcn_mfma_f32_16x16x32_bf16(yb, xa[ks], acc[nt], 0, 0, 0); }
}

__device__ __forceinline__ void r1_state_item(const Args& a, LAS unsigned char* lds, int it) {
    const int tid = ltid(), lane = tid & 63, wave = tid >> 6, r = lane & 15, q = lane >> 4, tp = tid >> 3, dg = tid & 7;
    const bf16* P = (const bf16*)(a.ws + WS_ACT); bf16* U = (bf16*)(a.ws + WS_H);
    int h, row0, pos0; bool rope;
    if (it < 512) { const int bh = it >> 5, c = it & 31; h = bh & 3; row0 = (bh >> 2) * SEQ + c * CH; pos0 = c * CH; rope = true; }
    else { const int j = it - 512, bh = j >> 1, cc = j & 1; h = bh & 3; row0 = MX + (bh >> 2) * CTXL + cc * CH; pos0 = 0; rope = false; }
    const float lgf = -__expf(a.in[10][h]) * 1.4426950408889634f, lgb = -__expf(a.in[10][4 + h]) * 1.4426950408889634f;
    LAS bf16* Kt = (LAS bf16*)lds; LAS bf16* Vf = (LAS bf16*)(lds + TILE_B); LAS bf16* Vb = (LAS bf16*)(lds + 2 * TILE_B);
    {
        float v[2][2][8];
        tile_load(P + (size_t)row0 * NIN + 512 + h * 128, NIN, tp, dg, v);
        if (rope) tile_rope(v, pos0 + 2 * tp, dg);
        tile_write_T(Kt, tp, dg, v, 0.08838834764831845f, 0.08838834764831845f);
        tile_load(P + (size_t)row0 * NIN + 1024 + h * 128, NIN, tp, dg, v);
        const float t0 = (float)(2 * tp), t1 = t0 + 1.0f;
        tile_write_T(Vf, tp, dg, v, exp2f((127.0f - t0) * lgf), exp2f((127.0f - t1) * lgf));
        tile_write_T(Vb, tp, dg, v, exp2f(t0 * lgb), exp2f(t1 * lgb));
    }
    __syncthreads();
    bf16x8 xf[4], xb[4];
#pragma unroll
    for (int ks = 0; ks < 4; ++ks) { xf[ks] = frag_T(Vf, 16 * wave + r, ks, q); xb[ks] = frag_T(Vb, 16 * wave + r, ks, q); }
    f32x4 af[8], ab[8];
#pragma unroll
    for (int nt = 0; nt < 8; ++nt) { af[nt] = (f32x4){0.f, 0.f, 0.f, 0.f}; ab[nt] = (f32x4){0.f, 0.f, 0.f, 0.f}; }
    strip_mma<true>(af, xf, Kt, r, q);
    strip_mma<true>(ab, xb, Kt, r, q);
    bf16* uf = U + ((size_t)(it * 2 + 0) * 128 + 16 * wave + r) * 128 + 4 * q;
    bf16* ub = U + ((size_t)(it * 2 + 1) * 128 + 16 * wave + r) * 128 + 4 * q;
#pragma unroll
    for (int nt = 0; nt < 8; ++nt) {
        u32x2 o; o.x = pk2(af[nt][0], af[nt][1]); o.y = pk2(af[nt][2], af[nt][3]); *(u32x2*)(uf + 16 * nt) = o;
        o.x = pk2(ab[nt][0], ab[nt][1]); o.y = pk2(ab[nt][2], ab[nt][3]); *(u32x2*)(ub + 16 * nt) = o;
    }
    __syncthreads();
}
__device__ __forceinline__ void r1_gmlp_item(const Args& a, LAS unsigned char* lds, int j) {
    const int tid = ltid(), lane = tid & 63, wave = tid >> 6, r = lane & 15, q = lane >> 4, tp = tid >> 3, dg = tid & 7;
    const bf16* P = (const bf16*)(a.ws + WS_ACT); bf16* MIX = (bf16*)(a.ws + WS_MIX);
    const int g = j & 3, bc = j >> 2, row0 = bc * CH;
    LAS bf16* Wsb = (LAS bf16*)lds; LAS bf16* Vn = (LAS bf16*)(lds + TILE_B);
    const float* Ws = a.in[11] + (size_t)g * CH * CH;
#pragma unroll
    for (int i = 0; i < 8; ++i) { const int p = (tid >> 5) + 16 * i, c4 = 4 * (tid & 31); const f32x4 w = *(const f32x4*)(Ws + p * CH + c4);
        u32x2 o; o.x = pk2(w.x, w.y); o.y = pk2(w.z, w.w); *(LAS u32x2*)(Wsb + p * TP + c4) = o; }
    {
        float v[2][2][8];
        tile_load(P + (size_t)row0 * NIN + 2560 + g * 128, NIN, tp, dg, v);
#pragma unroll
        for (int tk = 0; tk < 2; ++tk) {
            float s = 0.f;
#pragma unroll
            for (int h = 0; h < 2; ++h)
#pragma unroll
                for (int i = 0; i < 8; ++i) { v[tk][h][i] = gelu_tanh(v[tk][h][i]); s += v[tk][h][i]; }
            s += __shfl_xor(s, 1); s += __shfl_xor(s, 2); s += __shfl_xor(s, 4);
            const float mu = s * (1.0f / 128.0f); float qv = 0.f;
#pragma unroll
            for (int h = 0; h < 2; ++h)
#pragma unroll
                for (int i = 0; i < 8; ++i) { v[tk][h][i] -= mu; qv += v[tk][h][i] * v[tk][h][i]; }
            qv += __shfl_xor(qv, 1); qv += __shfl_xor(qv, 2); qv += __shfl_xor(qv, 4);
            const float rs = 1.0f / sqrtf(qv * (1.0f / 128.0f) + EPS);
#pragma unroll
            for (int h = 0; h < 2; ++h)
#pragma unroll
                for (int i = 0; i < 8; ++i) v[tk][h][i] *= rs;
        }
        tile_write_T(Vn, tp, dg, v, 1.0f, 1.0f);
    }
    __syncthreads();
    bf16x8 xa[4];
#pragma unroll
    for (int ks = 0; ks < 4; ++ks) xa[ks] = frag_R(Wsb, 16 * wave + r, ks, q);
    f32x4 acc[8];
#pragma unroll
    for (int nt = 0; nt < 8; ++nt) acc[nt] = (f32x4){0.f, 0.f, 0.f, 0.f};
    strip_mma<true>(acc, xa, Vn, r, q);
    const int p = 16 * wave + r; const float bs = a.in[12][g * CH + p];
    const bf16* up = P + (size_t)(row0 + p) * NIN + 2048 + g * 128 + 4 * q;
    bf16* op = MIX + (size_t)(row0 + p) * D + 512 + g * 128 + 4 * q;
#pragma unroll
    for (int nt = 0; nt < 8; ++nt) { const u32x2 uu = *(const u32x2*)(up + 16 * nt);
        const float o0 = gelu_tanh(bf_lo(uu.x)) * (acc[nt][0] + bs), o1 = gelu_tanh(bf_hi(uu.x)) * (acc[nt][1] + bs), o2 = gelu_tanh(bf_lo(uu.y)) * (acc[nt][2] + bs), o3 = gelu_tanh(bf_hi(uu.y)) * (acc[nt][3] + bs);
        u32x2 o; o.x = pk2(o0, o1); o.y = pk2(o2, o3); *(u32x2*)(op + 16 * nt) = o; }
    __syncthreads();
}
__device__ __forceinline__ void phase_r1(const Args& a, LAS unsigned char* lds) {
    for (int it = lbid(); it < 544 + 512; it += gridDim.x) { if (it < 544) r1_state_item(a, lds, it); else r1_gmlp_item(a, lds, it - 544); }
}
__device__ __forceinline__ void phase_r2(const Args& a) {
    bf16* U = (bf16*)(a.ws + WS_H);
    for (int gidx = lbid() * NTHR + ltid(); gidx < 16 * 2 * 4096; gidx += gridDim.x * NTHR) {
        const int bh = gidx >> 13, dir = (gidx >> 12) & 1, e4 = gidx & 4095, h = bh & 3;
        const float dec = __expf(-__expf(a.in[10][dir * 4 + h]) * 128.0f);
        const size_t eo = (size_t)dir * 16384 + 4 * e4;
        const u32x2 c0 = *(const u32x2*)(U + (size_t)(512 + bh * 2 + 0) * 32768 + eo), c1 = *(const u32x2*)(U + (size_t)(512 + bh * 2 + 1) * 32768 + eo);
        float s0, s1, s2, s3;
        if (dir == 0) { s0 = dec * bf_lo(c0.x) + bf_lo(c1.x); s1 = dec * bf_hi(c0.x) + bf_hi(c1.x); s2 = dec * bf_lo(c0.y) + bf_lo(c1.y); s3 = dec * bf_hi(c0.y) + bf_hi(c1.y); }
        else          { s0 = dec * bf_lo(c1.x) + bf_lo(c0.x); s1 = dec * bf_hi(c1.x) + bf_hi(c0.x); s2 = dec * bf_lo(c1.y) + bf_lo(c0.y); s3 = dec * bf_hi(c1.y) + bf_hi(c0.y); }
#pragma unroll 8
        for (int k = 0; k < NCH; ++k) { const int c = dir == 0 ? k : NCH - 1 - k;
            u32x2* p = (u32x2*)(U + (size_t)(bh * 32 + c) * 32768 + eo); const u32x2 t = *p;
            u32x2 o; o.x = pk2(s0, s1); o.y = pk2(s2, s3); *p = o;
            s0 = dec * s0 + bf_lo(t.x); s1 = dec * s1 + bf_hi(t.x); s2 = dec * s2 + bf_lo(t.y); s3 = dec * s3 + bf_hi(t.y); }
    }
}
__device__ __forceinline__ void r3_item(const Args& a, LAS unsigned char* lds, int it) {
    const int tid = ltid(), lane = tid & 63, wave = tid >> 6, r = lane & 15, q = lane >> 4, tp = tid >> 3, dg = tid & 7;
    const bf16* P = (const bf16*)(a.ws + WS_ACT); const bf16* S = (const bf16*)(a.ws + WS_H); bf16* MIX = (bf16*)(a.ws + WS_MIX);
    const int bh = it >> 5, c = it & 31, h = bh & 3, row0 = (bh >> 2) * SEQ + c * CH, pos0 = c * CH;
    const float lgf = -__expf(a.in[10][h]) * 1.4426950408889634f, lgb = -__expf(a.in[10][4 + h]) * 1.4426950408889634f;
    LAS bf16* Ks = (LAS bf16*)lds; LAS bf16* Vt = (LAS bf16*)(lds + TILE_B); LAS bf16* Sf = (LAS bf16*)(lds + 2 * TILE_B); LAS bf16* Sb = (LAS bf16*)(lds + 3 * TILE_B);
    {
        float v[2][2][8];
        tile_load(P + (size_t)row0 * NIN + 512 + h * 128, NIN, tp, dg, v);
        tile_rope(v, pos0 + 2 * tp, dg);
#pragma unroll
        for (int tk = 0; tk < 2; ++tk)
#pragma unroll
            for (int hh = 0; hh < 2; ++hh)
#pragma unroll
                for (int i = 0; i < 8; ++i) v[tk][hh][i] *= 0.08838834764831845f;
        tile_write_R(Ks, tp, dg, v);
        tile_load(P + (size_t)row0 * NIN + 1024 + h * 128, NIN, tp, dg, v);
        tile_write_T(Vt, tp, dg, v, 1.0f, 1.0f);
        const bf16* sf = S + (size_t)(it * 2 + 0) * 16384; const bf16* sb = S + (size_t)(it * 2 + 1) * 16384;
#pragma unroll
        for (int i = 0; i < 4; ++i) { const int id = tid + NTHR * i, rr = id >> 4, c8 = id & 15;
            *(LAS u32x4*)(Sf + rr * TP + 8 * c8) = *(const u32x4*)(sf + rr * 128 + 8 * c8);
            *(LAS u32x4*)(Sb + rr * TP + 8 * c8) = *(const u32x4*)(sb + rr * 128 + 8 * c8); }
    }
    const int irow = 16 * wave + r;
    bf16x8 xq[4];
    {
        const bf16* qp = P + (size_t)(row0 + irow) * NIN + h * 128 + 8 * q;
        float f[4][8];
#pragma unroll
        for (int ks = 0; ks < 4; ++ks) { const u32x4 rw = *(const u32x4*)(qp + 32 * ks);
            f[ks][0] = bf_lo(rw.x); f[ks][1] = bf_hi(rw.x); f[ks][2] = bf_lo(rw.y); f[ks][3] = bf_hi(rw.y); f[ks][4] = bf_lo(rw.z); f[ks][5] = bf_hi(rw.z); f[ks][6] = bf_lo(rw.w); f[ks][7] = bf_hi(rw.w); }
        const int n = pos0 + irow;
#pragma unroll
        for (int ks = 0; ks < 2; ++ks) { const float p = ks == 0 ? (float)(n >> 6) : (float)(n & 63);
#pragma unroll
            for (int i = 0; i < 8; ++i) { const int fi = 8 * q + i; const float fr = exp2f(-(float)fi * (13.287712379549449f / 32.0f)); float sn, cs; __sincosf(p * fr, &sn, &cs);
                const float t1 = f[ks][i], t2 = f[ks + 2][i]; f[ks][i] = t1 * cs - t2 * sn; f[ks + 2][i] = t1 * sn + t2 * cs; } }
#pragma unroll
        for (int ks = 0; ks < 4; ++ks) { u32x4 o; o.x = pk2(f[ks][0], f[ks][1]); o.y = pk2(f[ks][2], f[ks][3]); o.z = pk2(f[ks][4], f[ks][5]); o.w = pk2(f[ks][6], f[ks][7]); xq[ks] = __builtin_bit_cast(bf16x8, o); }
    }
    __syncthreads();
    f32x4 acc[8];
#pragma unroll
    for (int nt = 0; nt < 8; ++nt) acc[nt] = (f32x4){0.f, 0.f, 0.f, 0.f};
    strip_mma<false>(acc, xq, Ks, r, q);
    __syncthreads();
    LAS bf16* Ps = Ks;
#pragma unroll
    for (int nt = 0; nt < 8; ++nt) { float pv[4];
#pragma unroll
        for (int jj = 0; jj < 4; ++jj) { const int df = irow - (16 * nt + 4 * q + jj);
            const float m = df > 0 ? exp2f((float)df * lgf) : (df < 0 ? exp2f((float)(-df) * lgb) : 2.0f); pv[jj] = acc[nt][jj] * m; }
        u32x2 o; o.x = pk2(pv[0], pv[1]); o.y = pk2(pv[2], pv[3]); *(LAS u32x2*)(Ps + irow * TP + 16 * nt + 4 * q) = o; }
    const float xif = exp2f((float)(irow + 1) * lgf), xib = exp2f((float)(128 - irow) * lgb);
#pragma unroll
    for (int nt = 0; nt < 8; ++nt) acc[nt] = (f32x4){0.f, 0.f, 0.f, 0.f};
    strip_mma<false>(acc, xq, Sb, r, q);
    { const float rt = xib / xif;
#pragma unroll
      for (int nt = 0; nt < 8; ++nt) acc[nt] *= rt; }
    strip_mma<false>(acc, xq, Sf, r, q);
#pragma unroll
    for (int nt = 0; nt < 8; ++nt) acc[nt] *= xif;
    {
        bf16x8 xp[4];
#pragma unroll
        for (int ks = 0; ks < 4; ++ks) xp[ks] = frag_R(Ps, irow, ks, q);
        strip_mma<true>(acc, xp, Vt, r, q);
    }
    float ss = 0.f;
#pragma unroll
    for (int nt = 0; nt < 8; ++nt) ss += (acc[nt][0] * acc[nt][0] + acc[nt][1] * acc[nt][1]) + (acc[nt][2] * acc[nt][2] + acc[nt][3] * acc[nt][3]);
    ss += __shfl_xor(ss, 16); ss += __shfl_xor(ss, 32);
    const float rstd = 1.0f / sqrtf(ss * (1.0f / 128.0f) + EPS);
    const bf16* gp = P + (size_t)(row0 + irow) * NIN + 1536 + h * 128 + 4 * q;
    bf16* op = MIX + (size_t)(row0 + irow) * D + h * 128 + 4 * q;
#pragma unroll
    for (int nt = 0; nt < 8; ++nt) { const u32x2 gg = *(const u32x2*)(gp + 16 * nt);
        u32x2 o; o.x = pk2(acc[nt][0] * rstd * pg8::silu_f(bf_lo(gg.x)), acc[nt][1] * rstd * pg8::silu_f(bf_hi(gg.x)));
        o.y = pk2(acc[nt][2] * rstd * pg8::silu_f(bf_lo(gg.y)), acc[nt][3] * rstd * pg8::silu_f(bf_hi(gg.y)));
        *(u32x2*)(op + 16 * nt) = o; }
    __syncthreads();
}

#ifndef ONLY
#define ONLY (-1)
#endif
#define ON(p) (ONLY < 0 || ONLY == (p))
enum { PH_P0 = 0, PH_P1, PH_G1, PH_G2, PH_P2, PH_G3, PH_R1, PH_R2, PH_R3, PH_G4, PH_P3, PH_G5, PH_G6, PH_F, PH_N };

__global__ void __launch_bounds__(NTHR, 2) mk_fwd(Args a) {
    extern __shared__ __attribute__((aligned(16))) unsigned char lds_raw[];
    LAS unsigned char* lds = (LAS unsigned char*)lds_raw;
    cg::grid_group grid = cg::this_grid();
    volatile LAS unsigned* xbst = (volatile LAS unsigned*)(lds + LDS_BYTES - 16);
    if (threadIdx.x < 4) xbst[threadIdx.x] = 0u;
    __syncthreads();
    XcdBarrier xbar = xcd_barrier_post((unsigned*)(a.ws + WS_BAR), xbst);
    unsigned char* ws = a.ws;
    const float* mod = (const float*)(ws + WS_MOD);
    bf16* H = (bf16*)(ws + WS_H); bf16* ACT = (bf16*)(ws + WS_ACT); bf16* MIX = (bf16*)(ws + WS_MIX);
    float* X1C = (float*)(ws + WS_X1C);
    const int G = gridDim.x;
#ifdef LEAK_MASK
    unsigned long long leak = 0ull;
#endif
    for (int ph = a.ph_lo; ph < a.ph_hi; ++ph) {
        const int bx = lbid();
#ifdef LEAK_MASK
        const unsigned long long lk0 = __builtin_amdgcn_s_memrealtime();
#endif
        switch (ph) {
        case PH_P0: if constexpr (ON(PH_P0)) phase_p0(a, lds); break;
        case PH_P1: if constexpr (ON(PH_P1)) phase_normmod(a.in[0], a.in[2], MT, a.in[6], mod, 0, H); break;
        case PH_P2: if constexpr (ON(PH_P1)) phase_normmod(a.out, X1C, MT, a.in[6] + D, mod, 3, H); break;
        case PH_P3: if constexpr (ON(PH_P1)) phase_normmod(a.out, X1C, MX, a.in[6] + 2 * D, mod, 6, H); break;
        case PH_G1: case PH_G5: if constexpr (ON(PH_G1)) {
            const int M = ph == PH_G1 ? MT : MX;
            pg8::Gemm g{H, (const bf16*)(ws + (ph == PH_G1 ? WS_W1A : WS_W1B)), M, 2 * FF, D}; pg8::StaticOrder S; S.init(M, 2 * FF, G, bx);
            pg8::EpiSwiglu E{ACT, FF};
            pg8::gemm_phase<pg8::EpiSwiglu, pg8::StaticOrder, true, true>(lds, g, S, E);
        } break;
        case PH_G2: case PH_G4: case PH_G6: if constexpr (ON(PH_G2)) {
            pg8::Gemm g; pg8::EpiResid E;
            if (ph == PH_G2)      { g = pg8::Gemm{ACT, (const bf16*)(ws + WS_W2A), MT, D, FF}; E = pg8::EpiResid{a.in[0], a.in[2], a.out, X1C, mod, 2, 0.5f}; }
            else if (ph == PH_G4) { g = pg8::Gemm{MIX, (const bf16*)(ws + WS_WOUT), MX, D, D}; E = pg8::EpiResid{a.out, X1C, a.out, X1C, mod, 5, 1.0f}; }
            else                  { g = pg8::Gemm{ACT, (const bf16*)(ws + WS_W2B), MX, D, FF}; E = pg8::EpiResid{a.out, X1C, a.out, X1C, mod, 8, 0.5f}; }
            pg8::StaticOrder S; S.init(g.M, g.N, G, bx);
            pg8::gemm_phase<pg8::EpiResid, pg8::StaticOrder, true, true>(lds, g, S, E);
        } break;
        case PH_G3: if constexpr (ON(PH_G3)) {
            pg8::Gemm g{H, (const bf16*)(ws + WS_WIN), MT, NIN, D}; pg8::StaticOrder S; S.init(MT, NIN, G, bx);
            pg8::EpiPlainBf16 E{ACT, NIN};
            pg8::gemm_phase<pg8::EpiPlainBf16, pg8::StaticOrder, true, true>(lds, g, S, E);
        } break;
        case PH_R1: if constexpr (ON(PH_R1)) phase_r1(a, lds); break;
        case PH_R2: if constexpr (ON(PH_R2)) phase_r2(a); break;
        case PH_R3: if constexpr (ON(PH_R3)) for (int it = bx; it < 512; it += G) r3_item(a, lds, it); break;
        case PH_F: if constexpr (ON(PH_F)) phase_final(a.out, a.in[16]); break;
        default: break;
        }
        if (ph + 1 < a.ph_hi) {
            if (a.ph_hi > PH_N) grid.sync();
            xcd_barrier(xbar);
        }
#ifdef LEAK_MASK
        if ((LEAK_MASK >> ph) & 1) leak += __builtin_amdgcn_s_memrealtime() - lk0;
#endif
    }
#ifdef LEAK_MASK
    if (blockIdx.x == 0) { const unsigned long long t0 = __builtin_amdgcn_s_memrealtime(); while (__builtin_amdgcn_s_memrealtime() - t0 < leak) __builtin_amdgcn_s_sleep(8); }
#endif
}

extern "C" void kernel_launch(void* const* d_in, const int* in_sizes, int n_in, void* d_out, int out_size, void* d_ws, size_t ws_size, hipStream_t stream) {
    static int grid = 0;
    if (grid == 0) {
        if (n_in != 17 || out_size != MX * D || ws_size < WS_END) { fprintf(stderr, "kernel_launch: unexpected shapes (n_in %d out %d ws %zu)\n", n_in, out_size, ws_size); grid = -1; return; }
        int dev = 0, cus = 0, per_cu = 0;
        hipGetDevice(&dev); hipDeviceGetAttribute(&cus, hipDeviceAttributeMultiprocessorCount, dev);
        if (hipFuncSetAttribute((const void*)mk_fwd, hipFuncAttributeMaxDynamicSharedMemorySize, LDS_BYTES) != hipSuccess) { fprintf(stderr, "kernel_launch: hipFuncSetAttribute failed\n"); grid = -1; return; }
        if (hipOccupancyMaxActiveBlocksPerMultiprocessor(&per_cu, (const void*)mk_fwd, NTHR, LDS_BYTES) != hipSuccess || per_cu < 1) { fprintf(stderr, "kernel_launch: occupancy query failed (%d)\n", per_cu); (void)hipGetLastError(); per_cu = 1; }
        grid = cus * per_cu;
        fprintf(stderr, "kernel_launch: %d CUs x %d = grid %d\n", cus, per_cu, grid);
    }
    if (grid < 0) return;
    if (hipMemsetAsync((char*)d_ws + WS_BAR, 0, XCD_BAR_WORDS * 4, stream) != hipSuccess) { fprintf(stderr, "kernel_launch: memset failed\n"); return; }
    Args a{};
    for (int i = 0; i < 17; ++i) a.in[i] = (const float*)d_in[i];
    a.out = (float*)d_out; a.ws = (unsigned char*)d_ws; a.ph_lo = 0; a.ph_hi = PH_N;
#ifndef N_LAUNCH_PER_PHASE
    void* args[] = {&a};
    const hipError_t e = hipLaunchCooperativeKernel((const void*)mk_fwd, dim3(grid), dim3(NTHR), args, LDS_BYTES, stream);
    if (e != hipSuccess) fprintf(stderr, "kernel_launch: cooperative launch failed: %s (grid %d)\n", hipGetErrorString(e), grid);
#else
    for (int p = 0; p < PH_N; ++p) { if (!((PHASE_MASK >> p) & 1)) continue; a.ph_lo = p; a.ph_hi = p + 1; hipLaunchKernelGGL(mk_fwd, dim3(grid), dim3(NTHR), LDS_BYTES, stream, a); }
#endif
}
```

```cpp
#include <hip/hip_runtime.h>
#include <hip/hip_cooperative_groups.h>
#include <cstdio>
#include <cstdint>
namespace cg = cooperative_groups;
__device__ __forceinline__ int ltid() { int t = threadIdx.x; asm volatile("" : "+v"(t)); return t; }
__device__ __forceinline__ int lbid() { int t = blockIdx.x; asm volatile("" : "+s"(t)); return t; }
typedef float f32x2_t __attribute__((ext_vector_type(2))); typedef __bf16 bf16x2_t __attribute__((ext_vector_type(2)));
__device__ __forceinline__ unsigned cvtpk(float lo, float hi) { f32x2_t v = {lo, hi}; bf16x2_t b = __builtin_convertvector(v, bf16x2_t); return __builtin_bit_cast(unsigned, b); }
namespace pg8 {
#define PG8_LAS __attribute__((address_space(3)))
typedef unsigned short bf16_t;
typedef short bf16x8 __attribute__((ext_vector_type(8)));
typedef float f32x4 __attribute__((ext_vector_type(4)));
typedef unsigned u32x4 __attribute__((ext_vector_type(4)));
constexpr int BM = 256, BK = 64, HALF = 128, HTB = HALF * BK * 2  , STAGE_BYTES = 8 * HTB, NXCD = 8, WGM = 8;

__host__ __device__ __forceinline__ int lds_byte(int r, int c) { const int st = (r >> 4) * 2 + (c >> 5), rr = r & 15, cc = c & 31, ob = rr * 64 + cc * 2; return st * 1024 + (ob ^ (((ob >> 9) & 1) << 5)); }
__host__ __device__ __forceinline__ void stage_rc(int b, int& R, int& C) { const int st = b / 1024, sb = b % 1024, swz = sb ^ (((sb >> 9) & 1) << 5); R = (st >> 1) * 16 + swz / 64; C = (st & 1) * 32 + (swz % 64) / 2; }
__host__ __device__ __forceinline__ int perm32(int rho) { const int n = rho >> 4, i = rho & 15; return 8 * (i >> 2) + 4 * n + (i & 3); }

struct Unit { int pm, pn; };
struct Gemm { const bf16_t* A; const bf16_t* Bt; int M, N, K; };

struct StaticOrder {
    int nM, nN, nwg, G, c;
    __host__ __device__ void init(int M, int N, int G_, int c_) { nM = M / BM; nN = N / BM; nwg = nM * nN; G = G_; c = c_; }
    __host__ __device__ bool next(int i, Unit& u) const {
        const long L = (long)i * G + c; if (L >= nwg) return false;
        int wgid = (int)L; { const int q = nwg / NXCD, r = nwg % NXCD, xcd = wgid % NXCD, off = wgid / NXCD; wgid = (xcd < r ? xcd * (q + 1) : r * (q + 1) + (xcd - r) * q) + off; }
        const int nig = WGM * nN, gid = wgid / nig, fm = gid * WGM, gsz = (nM - fm) < WGM ? (nM - fm) : WGM;
        u.pm = fm + ((wgid % nig) % gsz); u.pn = (wgid % nig) / gsz; return true;
    }
    __device__ __forceinline__ void a_ready(const Unit&) const {}
    __device__ __forceinline__ void done(const Unit&) const {}
};

__device__ __forceinline__ unsigned cvt_pk_bf16(float lo, float hi) { unsigned r; asm volatile("v_cvt_pk_bf16_f32 %0, %1, %2" : "=v"(r) : "v"(lo), "v"(hi)); return r; }
typedef float f32x2 __attribute__((ext_vector_type(2)));

__device__ __forceinline__ float silu_f(float x) { return x * __builtin_amdgcn_rcpf(1.0f + __expf(-x)); }

struct EpiSwiglu {
    static constexpr bool PERM = true, AFTER_DRAIN = false;
    bf16_t* O; int ldc;
    __device__ __forceinline__ void operator()(const f32x4 (&acc)[2][2][4][2], const Unit& u, int wr, int wc, int fr, int fq) const {
        const int row0 = u.pm * BM + wr * 64 + fr, col0 = u.pn * HALF + wc * 32 + 8 * fq;
#pragma unroll
        for (int ai = 0; ai < 2; ++ai)
#pragma unroll
            for (int m = 0; m < 4; ++m) {
                bf16_t* rowp = O + (size_t)(row0 + ai * HALF + m * 16) * ldc + col0;
                const f32x4 g0 = acc[ai][0][m][0], g1 = acc[ai][0][m][1], u0 = acc[ai][1][m][0], u1 = acc[ai][1][m][1];
                u32x4 w;
                w.x = ::cvtpk(silu_f(g0[0]) * u0[0], silu_f(g0[1]) * u0[1]); w.y = ::cvtpk(silu_f(g0[2]) * u0[2], silu_f(g0[3]) * u0[3]);
                w.z = ::cvtpk(silu_f(g1[0]) * u1[0], silu_f(g1[1]) * u1[1]); w.w = ::cvtpk(silu_f(g1[2]) * u1[2], silu_f(g1[3]) * u1[3]);
                *(u32x4*)rowp = w;
            }
    }
};
struct EpiPlainBf16 {
    static constexpr bool PERM = true, AFTER_DRAIN = false;
    bf16_t* O; int ldc;
    __device__ __forceinline__ void operator()(const f32x4 (&acc)[2][2][4][2], const Unit& u, int wr, int wc, int fr, int fq) const {
        const int row0 = u.pm * BM + wr * 64 + fr, col0 = u.pn * BM + wc * 32 + 8 * fq;
#pragma unroll
        for (int ai = 0; ai < 2; ++ai)
#pragma unroll
            for (int m = 0; m < 4; ++m) {
                bf16_t* rowp = O + (size_t)(row0 + ai * HALF + m * 16) * ldc + col0;
#pragma unroll
                for (int bj = 0; bj < 2; ++bj) {
                    const f32x4 v0 = acc[ai][bj][m][0], v1 = acc[ai][bj][m][1];
                    u32x4 w; w.x = ::cvtpk(v0[0], v0[1]); w.y = ::cvtpk(v0[2], v0[3]); w.z = ::cvtpk(v1[0], v1[1]); w.w = ::cvtpk(v1[2], v1[3]);
                    *(u32x4*)(rowp + bj * HALF) = w;
                }
            }
    }
};
struct EpiResid {
    static constexpr bool PERM = false, AFTER_DRAIN = false;
    const float* xin_lat; const float* xin_ctx; float* out_lat; float* out_ctx; const float* mod; int slot; float coef;
    __device__ __forceinline__ void operator()(const f32x4 (&acc)[2][2][4][2], const Unit& u, int wr, int wc, int fr, int fq) const {
        const bool isctx = u.pm >= 64; const int mb = isctx ? 4 : (u.pm >> 4);
        const float* xin = isctx ? xin_ctx : xin_lat; float* out = isctx ? out_ctx : out_lat;
        const int row0 = (isctx ? u.pm - 64 : u.pm) * BM + wr * 64 + fr, col0 = u.pn * BM + wc * 32 + 4 * fq;
        const float* mrow = mod + mb * 9216 + slot * 1024 + col0;
        f32x4 gv[2][2];
#pragma unroll
        for (int bj = 0; bj < 2; ++bj)
#pragma unroll
            for (int n = 0; n < 2; ++n) gv[bj][n] = *(const f32x4*)(mrow + bj * HALF + n * 16) * coef;
#pragma unroll
        for (int ai = 0; ai < 2; ++ai)
#pragma unroll
            for (int m = 0; m < 4; ++m) { const size_t off = (size_t)(row0 + ai * HALF + m * 16) * 1024 + col0;
#pragma unroll
                for (int bj = 0; bj < 2; ++bj)
#pragma unroll
                    for (int n = 0; n < 2; ++n) { const f32x4 xi = *(const f32x4*)(xin + off + bj * HALF + n * 16);
                        *(f32x4*)(out + off + bj * HALF + n * 16) = xi + gv[bj][n] * acc[ai][bj][m][n]; } }
    }
};

template <class Epi, class Sched, bool ALIGN_EPI = false, bool SP2 = false>
__device__ __forceinline__ void gemm_phase(PG8_LAS unsigned char* lds, const Gemm g, const Sched& S, const Epi& E) {
    const int tid = ltid(), wid = __builtin_amdgcn_readfirstlane(tid >> 6), lane = tid & 63, wr = wid >> 2, wc = wid & 3, fr = lane & 15, fq = lane >> 4;
    const int K = g.K, nt = K / BK;
    unsigned voffA[2], voffB[2];
#pragma unroll
    for (int i = 0; i < 2; ++i) { int R, C; stage_rc(tid * 16 + i * 8192, R, C); const int Rb = Epi::PERM ? ((R & ~31) + perm32(R & 31)) : R;
        voffA[i] = (unsigned)(R * K + C) * 2u; voffB[i] = (unsigned)(Rb * K + C) * 2u; }
    const size_t kstep = (size_t)(BK * 2);
    const size_t hstep = (size_t)HALF * K * 2;
    const size_t tstep = 2 * hstep;
    const unsigned ldsw = (unsigned)wid * 1024u;
    const int aoff = lds_byte(wr * 64 + fr, fq * 8), boff = lds_byte(wc * 32 + fr, fq * 8);
#define PG8_SA(b, h) (((b) * 2 + (h)) * HTB)
#define PG8_SB(b, h) ((4 + (b) * 2 + (h)) * HTB)
#define PG8_STAGE(bufoff, gbase, voff) do { _Pragma("unroll") for (int _i = 0; _i < 2; ++_i) \
        __builtin_amdgcn_global_load_lds((const unsigned*)((const char*)(gbase) + (voff)[_i]), (PG8_LAS unsigned*)(lds + (bufoff) + ldsw + _i * 8192), 16, 0, 0); } while (0)
#define PG8_LDA(dst, b, h) do { _Pragma("unroll") for (int m = 0; m < 4; ++m) _Pragma("unroll") for (int k = 0; k < 2; ++k) dst[m][k] = *(const PG8_LAS bf16x8*)(lds + PG8_SA(b, h) + aoff + m * 2048 + k * 1024); } while (0)
#define PG8_LDB(dst, b, h) do { _Pragma("unroll") for (int n = 0; n < 2; ++n) _Pragma("unroll") for (int k = 0; k < 2; ++k) dst[n][k] = *(const PG8_LAS bf16x8*)(lds + PG8_SB(b, h) + boff + n * 2048 + k * 1024); } while (0)
#define PG8_MMA(ai, bj, At, Bt) do { __builtin_amdgcn_s_setprio(1); _Pragma("unroll") for (int m = 0; m < 4; ++m) _Pragma("unroll") for (int n = 0; n < 2; ++n) _Pragma("unroll") for (int k = 0; k < 2; ++k) \
        acc[ai][bj][m][n] = __builtin_amdgcn_mfma_f32_16x16x32_bf16(Bt[n][k], At[m][k], acc[ai][bj][m][n], 0, 0, 0); __builtin_amdgcn_s_setprio(0); } while (0)
#define PG8_WAIT_V(n) asm volatile("s_waitcnt vmcnt(" #n ")" ::: "memory")
#define PG8_WAIT_L(n) asm volatile("s_waitcnt lgkmcnt(" #n ")" ::: "memory")
#define PG8_BAR __builtin_amdgcn_s_barrier()
#define PG8_SCHED __builtin_amdgcn_sched_barrier(0)
    Unit cur, nxt; int ui = 0;
    if (!S.next(0, cur)) return;
    f32x4 acc[2][2][4][2];
#pragma unroll
    for (int a = 0; a < 2; ++a)
#pragma unroll
        for (int b = 0; b < 2; ++b)
#pragma unroll
            for (int m = 0; m < 4; ++m)
#pragma unroll
                for (int n = 0; n < 2; ++n) acc[a][b][m][n] = (f32x4){0.f, 0.f, 0.f, 0.f};
    bf16x8 At[4][2], B0[2][2], B1[2][2];
    const char* cA = (const char*)g.A + (size_t)cur.pm * tstep; const char* cB = (const char*)g.Bt + (size_t)cur.pn * tstep;
    S.a_ready(cur);
    if constexpr (SP2) {
        PG8_STAGE(PG8_SB(0, 0), cB, voffB); PG8_STAGE(PG8_SB(0, 1), cB + hstep, voffB); PG8_STAGE(PG8_SA(0, 0), cA, voffA); PG8_STAGE(PG8_SA(0, 1), cA + hstep, voffA);
        if (wr == 1) PG8_BAR;
        PG8_WAIT_V(2); PG8_BAR;
        PG8_STAGE(PG8_SB(1, 0), cB + kstep, voffB); PG8_STAGE(PG8_SA(1, 0), cA + kstep, voffA); PG8_STAGE(PG8_SB(1, 1), cB + hstep + kstep, voffB);
        PG8_WAIT_V(6); PG8_BAR;
    } else {
        PG8_STAGE(PG8_SB(0, 0), cB, voffB); PG8_STAGE(PG8_SA(0, 0), cA, voffA); PG8_STAGE(PG8_SB(0, 1), cB + hstep, voffB); PG8_STAGE(PG8_SA(0, 1), cA + hstep, voffA);
        if (wr == 1) PG8_BAR;
        PG8_WAIT_V(4); PG8_BAR;
        PG8_STAGE(PG8_SB(1, 0), cB + kstep, voffB); PG8_STAGE(PG8_SA(1, 0), cA + kstep, voffA); PG8_STAGE(PG8_SB(1, 1), cB + hstep + kstep, voffB);
        PG8_WAIT_V(6); PG8_BAR;
    }
    for (;;) {
        const bool has_next = S.next(ui + 1, nxt);
        const char* nA = has_next ? (const char*)g.A + (size_t)nxt.pm * tstep : cA; const char* nB = has_next ? (const char*)g.Bt + (size_t)nxt.pn * tstep : cB;
        for (int t = 0; t < nt; t += 2) {
            const bool last = (t == nt - 2);
            const char* a1 = cA + (size_t)(t + 1) * kstep;
            const char* a2 = last ? nA : cA + (size_t)(t + 2) * kstep; const char* b2 = last ? nB : cB + (size_t)(t + 2) * kstep;
            const char* a3 = a2 + kstep; const char* b3 = b2 + kstep;
            if (last && has_next) S.a_ready(nxt);
            if constexpr (SP2) {
            PG8_LDB(B0, 0, 0); PG8_LDB(B1, 0, 1); PG8_SCHED; PG8_LDA(At, 0, 0); PG8_STAGE(PG8_SA(1, 1), a1 + hstep, voffA);
            PG8_WAIT_V(8); PG8_WAIT_L(0); PG8_BAR; PG8_MMA(0, 0, At, B0); PG8_MMA(0, 1, At, B1); PG8_BAR; PG8_SCHED;
            PG8_LDA(At, 0, 1); PG8_STAGE(PG8_SB(0, 0), b2, voffB); PG8_STAGE(PG8_SB(0, 1), b2 + hstep, voffB); PG8_STAGE(PG8_SA(0, 0), a2, voffA);
            PG8_WAIT_V(8); PG8_WAIT_L(0); PG8_BAR; PG8_MMA(1, 0, At, B0); PG8_MMA(1, 1, At, B1); PG8_BAR; PG8_SCHED;
            PG8_LDB(B0, 1, 0); PG8_LDB(B1, 1, 1); PG8_SCHED; PG8_LDA(At, 1, 0); PG8_STAGE(PG8_SA(0, 1), a2 + hstep, voffA);
            PG8_WAIT_V(8); PG8_WAIT_L(0); PG8_BAR; PG8_MMA(0, 0, At, B0); PG8_MMA(0, 1, At, B1); PG8_BAR; PG8_SCHED;
            PG8_LDA(At, 1, 1); PG8_STAGE(PG8_SB(1, 0), b3, voffB); PG8_STAGE(PG8_SB(1, 1), b3 + hstep, voffB); PG8_STAGE(PG8_SA(1, 0), a3, voffA);
            PG8_WAIT_V(8); PG8_WAIT_L(0); PG8_BAR; PG8_MMA(1, 0, At, B0); PG8_MMA(1, 1, At, B1); PG8_BAR; PG8_SCHED;
            } else {
            PG8_LDB(B0, 0, 0); PG8_SCHED; PG8_LDA(At, 0, 0); PG8_STAGE(PG8_SA(1, 1), a1 + hstep, voffA);
            PG8_WAIT_L(8); PG8_BAR; PG8_WAIT_L(0); PG8_MMA(0, 0, At, B0); PG8_BAR; PG8_SCHED;
            PG8_LDB(B1, 0, 1); PG8_STAGE(PG8_SB(0, 0), b2, voffB);
            PG8_BAR; PG8_WAIT_L(0); PG8_MMA(0, 1, At, B1); PG8_BAR;
            PG8_LDA(At, 0, 1); PG8_STAGE(PG8_SA(0, 0), a2, voffA);
            PG8_BAR; PG8_WAIT_L(0); PG8_MMA(1, 0, At, B0); PG8_BAR; PG8_SCHED;
            PG8_STAGE(PG8_SB(0, 1), b2 + hstep, voffB);
            PG8_WAIT_V(6); PG8_BAR; PG8_MMA(1, 1, At, B1); PG8_BAR;
            PG8_LDB(B0, 1, 0); PG8_SCHED; PG8_LDA(At, 1, 0); PG8_STAGE(PG8_SA(0, 1), a2 + hstep, voffA);
            PG8_WAIT_L(8); PG8_BAR; PG8_WAIT_L(0); PG8_MMA(0, 0, At, B0); PG8_BAR; PG8_SCHED;
            PG8_LDB(B1, 1, 1); PG8_STAGE(PG8_SB(1, 0), b3, voffB);
            PG8_BAR; PG8_WAIT_L(0); PG8_MMA(0, 1, At, B1); PG8_BAR;
            PG8_LDA(At, 1, 1); PG8_STAGE(PG8_SA(1, 0), a3, voffA);
            PG8_BAR; PG8_WAIT_L(0); PG8_MMA(1, 0, At, B0); PG8_BAR; PG8_SCHED;
            PG8_STAGE(PG8_SB(1, 1), b3 + hstep, voffB);
            PG8_WAIT_V(6); PG8_BAR; PG8_MMA(1, 1, At, B1); PG8_BAR;
            }
        }
        if constexpr (ALIGN_EPI) { if (wr == 0) PG8_BAR; }
        if constexpr (!Epi::AFTER_DRAIN) { E(acc, cur, wr, wc, fr, fq); S.done(cur); }
        if (!has_next) break;
#pragma unroll
        for (int a = 0; a < 2; ++a)
#pragma unroll
            for (int b = 0; b < 2; ++b)
#pragma unroll
                for (int m = 0; m < 4; ++m)
#pragma unroll
                    for (int n = 0; n < 2; ++n) acc[a][b][m][n] = (f32x4){0.f, 0.f, 0.f, 0.f};
        cur = nxt; cA = nA; cB = nB; ++ui;
        if constexpr (ALIGN_EPI) { if (wr == 1) PG8_BAR; }
    }
    PG8_WAIT_V(0);
    if constexpr (!ALIGN_EPI) { if (wr == 0) PG8_BAR; }
    PG8_BAR;
    if constexpr (Epi::AFTER_DRAIN) { E.fused(acc, cur, wr, wc, fr, fq, lds, wid, lane); S.done(cur); }
#undef PG8_SA
#undef PG8_SB
#undef PG8_STAGE
#undef PG8_LDA
#undef PG8_LDB
#undef PG8_MMA
#undef PG8_WAIT_V
#undef PG8_WAIT_L
#undef PG8_BAR
#undef PG8_SCHED
}
}
#define XB_TMO      128
#define XB_XCNT(j)  (256  + 64 * (j))
#define XB_XSUB(j)  (1280 + 64 * (j))
#define XB_XGEN(j)  (2304 + 64 * (j))
#define XB_TOP      3328
#define XB_TOPGEN   3392
#define XCD_BAR_WORDS 3456
#define XB_SPIN_CAP (1u << 18)
#define LAS __attribute__((address_space(3)))

__device__ __forceinline__ unsigned xb_ld(unsigned* p)              { return __hip_atomic_load(p, __ATOMIC_RELAXED, __HIP_MEMORY_SCOPE_AGENT); }
__device__ __forceinline__ unsigned xb_add(unsigned* p, unsigned v) { return __hip_atomic_fetch_add(p, v, __ATOMIC_RELAXED, __HIP_MEMORY_SCOPE_AGENT); }
__device__ __forceinline__ unsigned xb_xcc_id() { return (unsigned)__builtin_amdgcn_s_getreg((3 << 11) | 20) & 0xFu; }
#define XB_SPIN(cond, bar) do { unsigned _sp = 0; while (cond) { __builtin_amdgcn_s_sleep(1); \
    if ((++_sp & 255u) == 0u) { if (xb_ld(&(bar)[XB_TMO])) break; if (_sp > XB_SPIN_CAP) { atomicAdd(&(bar)[XB_TMO], 1u); break; } } } } while (0)

struct XcdBarrier {
    unsigned* bar; unsigned x;
    volatile LAS unsigned* st;
};

__device__ __forceinline__ XcdBarrier xcd_barrier_post(unsigned* bar, volatile LAS unsigned* st) {
    XcdBarrier b; b.bar = bar; b.x = xb_xcc_id(); b.st = st;
    if (threadIdx.x == 0) (void)xb_add(&bar[XB_XCNT(b.x)], 1u);
    return b;
}
__device__ __forceinline__ void xcd_barrier_complete(unsigned* bar, unsigned x, unsigned& nloc, unsigned& nx) {
    const unsigned G = gridDim.x * gridDim.y * gridDim.z;
    unsigned sum, cnt, mine, sp = 0u;
    for (;;) {
        sum = 0u; cnt = 0u; mine = 0u;
#pragma unroll
        for (unsigned j = 0; j < 16; ++j) { const unsigned c = xb_ld(&bar[XB_XCNT(j)]); sum += c; cnt += (c > 0u) ? 1u : 0u; mine = (j == x) ? c : mine; }
        if (sum == G) break;
        __builtin_amdgcn_s_sleep(1);
        if ((++sp & 255u) == 0u) { if (xb_ld(&bar[XB_TMO])) break; if (sp > XB_SPIN_CAP) { atomicAdd(&bar[XB_TMO], 1u); break; } }
    }
    nloc = mine > 0u ? mine : 1u; nx = cnt > 0u ? cnt : 1u;
}

__device__ __forceinline__ void xcd_barrier(const XcdBarrier& b) {
    asm volatile("s_waitcnt vmcnt(0)" ::: "memory");
    __syncthreads();
    if (threadIdx.x == 0) {
        unsigned* bar = b.bar;
        __builtin_amdgcn_s_waitcnt(0);
        unsigned nloc = b.st[0], nx = b.st[1];
        if (nloc == 0u) { xcd_barrier_complete(bar, b.x, nloc, nx); b.st[0] = nloc; b.st[1] = nx; }
        const unsigned old = xb_add(&bar[XB_XSUB(b.x)], 1u);
        const unsigned gen = old / nloc;
        if (old + 1u == (gen + 1u) * nloc) {
            __builtin_amdgcn_fence(__ATOMIC_RELEASE, "agent");
            asm volatile("s_waitcnt vmcnt(0)" ::: "memory");
            const unsigned og = xb_add(&bar[XB_TOP], 1u);
            const unsigned tg = og / nx;
            if (og + 1u == (tg + 1u) * nx) xb_add(&bar[XB_TOPGEN], 1u);
            else XB_SPIN(xb_ld(&bar[XB_TOPGEN]) == tg, bar);
            __builtin_amdgcn_fence(__ATOMIC_ACQUIRE, "agent");
            xb_add(&bar[XB_XGEN(b.x)], 1u);
            asm volatile("s_waitcnt vmcnt(0)" ::: "memory");
        } else {
            XB_SPIN(xb_ld(&bar[XB_XGEN(b.x)]) == gen, bar);
            __builtin_amdgcn_fence(__ATOMIC_ACQUIRE, "agent");
            asm volatile("s_waitcnt vmcnt(0)" ::: "memory");
        }
    }
    __syncthreads();
}

#define LAS __attribute__((address_space(3)))
typedef unsigned short bf16;
typedef float f32x4 __attribute__((ext_vector_type(4)));
typedef short bf16x8 __attribute__((ext_vector_type(8)));
typedef unsigned u32x4 __attribute__((ext_vector_type(4)));
typedef unsigned u32x2 __attribute__((ext_vector_type(2)));

constexpr int D = 1024, NB = 4, SEQ = 4096, CTXL = 256, MX = NB * SEQ, MC = NB * CTXL, MT = MX + MC;
constexpr int FF = 2816, NIN = 3072, NMODC = 9 * D;
constexpr int CH = 128, NCH = SEQ / CH, NHEAD = 4;
constexpr float EPS = 1e-6f;
constexpr int NTHR = 512, NWAVES = 8;
constexpr int LDS_BYTES = 147456;
constexpr int TP = 136;
constexpr int TILE_B = 128 * TP * 2;
static_assert(4 * TILE_B <= LDS_BYTES, "lds");

constexpr size_t MiB = 1u << 20;
constexpr size_t WS_MOD = 0;
constexpr size_t WS_BAR = 512 * 1024;
constexpr size_t WS_W1A = 1 * MiB, WS_W2A = 12 * MiB, WS_WIN = 18 * MiB, WS_WOUT = 24 * MiB, WS_W1B = 26 * MiB, WS_W2B = 37 * MiB;
constexpr size_t WS_X1C = 43 * MiB;
constexpr size_t WS_H = 47 * MiB;
constexpr size_t WS_MIX = 81 * MiB;
constexpr size_t WS_ACT = 113 * MiB;
constexpr size_t WS_END = 215 * MiB;

struct Args { const float* in[17]; float* out; unsigned char* ws; int ph_lo, ph_hi; };

__device__ __forceinline__ unsigned pk2(float lo, float hi) { return cvtpk(lo, hi); }
__device__ __forceinline__ float bf_lo(unsigned w) { return __uint_as_float(w << 16); }
__device__ __forceinline__ float bf_hi(unsigned w) { return __uint_as_float(w & 0xffff0000u); }
__device__ __forceinline__ float wave_sum(float v) {
#pragma unroll
    for (int o = 1; o < 64; o <<= 1) v += __shfl_xor(v, o);
    return v;
}
__device__ __forceinline__ float gelu_tanh(float x) {
    const float z = 0.7978845608028654f * (x + 0.044715f * x * x * x);
    const float e = __expf(2.0f * z);
    const float t = 1.0f - 2.0f * __builtin_amdgcn_rcpf(1.0f + e);
    return 0.5f * x * (1.0f + t);
}

__device__ __forceinline__ void transpose_item(const float* W, int N, int K, bf16* WT, int k0, int n0, int drow0, LAS float* scr, int lane) {
    const int kq = lane >> 3, n4 = (lane & 7) * 4;
    f32x4 v[8];
#pragma unroll
    for (int i = 0; i < 8; ++i) v[i] = *(const f32x4*)(W + (size_t)(k0 + kq + 8 * i) * N + n0 + n4);
#pragma unroll
    for (int i = 0; i < 8; ++i) { LAS float* d = scr + (kq + 8 * i) * 33 + n4; d[0] = v[i].x; d[1] = v[i].y; d[2] = v[i].z; d[3] = v[i].w; }
    asm volatile("s_waitcnt lgkmcnt(0)" ::: "memory");
    const int c = lane & 7;
#pragma unroll
    for (int j = 0; j < 4; ++j) { const int n = (lane >> 3) + 8 * j; const LAS float* s = scr + (8 * c) * 33 + n;
        u32x4 o; o.x = pk2(s[0 * 33], s[1 * 33]); o.y = pk2(s[2 * 33], s[3 * 33]); o.z = pk2(s[4 * 33], s[5 * 33]); o.w = pk2(s[6 * 33], s[7 * 33]);
        *(u32x4*)(WT + (size_t)(drow0 + n) * K + k0 + 8 * c) = o; }
    asm volatile("s_waitcnt lgkmcnt(0)" ::: "memory");
}
__device__ __forceinline__ int w1_drow(int n0) { return n0 < FF ? (n0 >> 7) * 256 + (n0 & 127) : ((n0 - FF) >> 7) * 256 + 128 + ((n0 - FF) & 127); }

__device__ __forceinline__ void phase_p0(const Args& a, LAS unsigned char* lds) {
    const int tid = ltid(), lane = tid & 63, wave = tid >> 6;
    unsigned char* ws = a.ws;
    if (lbid() < 144 || gridDim.x < 144) {
        for (int cg0 = lbid(); cg0 < 144; cg0 += gridDim.x) {
            LAS float* sil = (LAS float*)lds;
            LAS float* red = (LAS float*)(lds + 20480);
            for (int i = tid; i < 5 * 1024; i += NTHR) { const int r = i >> 10, k = i & 1023; const float v = r < 4 ? a.in[1][r * 1024 + k] : a.in[3][k]; sil[i] = pg8::silu_f(v); }
            __syncthreads();
            const int cl = tid & 15, ks = tid >> 4, j0 = cg0 * 64 + 4 * cl;
            const float* wa = a.in[4] + (size_t)(ks * 32) * NMODC + j0;
            f32x4 acc[5];
#pragma unroll
            for (int r = 0; r < 5; ++r) acc[r] = (f32x4){0.f, 0.f, 0.f, 0.f};
#pragma unroll 8
            for (int k = 0; k < 32; ++k) { const f32x4 w = *(const f32x4*)(wa + (size_t)k * NMODC);
#pragma unroll
                for (int r = 0; r < 5; ++r) acc[r] += w * sil[r * 1024 + ks * 32 + k]; }
#pragma unroll
            for (int r = 0; r < 5; ++r) *(LAS f32x4*)(red + (ks * 5 + r) * 64 + 4 * cl) = acc[r];
            __syncthreads();
            if (tid < 320) { const int r = tid >> 6, col = tid & 63; float s = a.in[5][cg0 * 64 + col];
                for (int k = 0; k < 32; ++k) s += red[(k * 5 + r) * 64 + col];
                ((float*)(ws + WS_MOD))[r * NMODC + cg0 * 64 + col] = s; }
            __syncthreads();
        }
    }
    LAS float* scr = (LAS float*)(lds + wave * 16384);
    const int gw = lbid() * NWAVES + wave, NGW = gridDim.x * NWAVES;
    constexpr int I_W1 = (D / 64) * (2 * FF / 32), I_W2 = (FF / 64) * (D / 32), I_IN = (D / 64) * (NIN / 32), I_OUT = (D / 64) * (D / 32);
    constexpr int NITEMS = 2 * I_W1 + 2 * I_W2 + I_IN + I_OUT;
    for (int it = gw; it < NITEMS; it += NGW) {
        int r = it; const float* W; bf16* WT; int N, K; bool isw1 = false;
        if (r < I_W1) { W = a.in[7]; WT = (bf16*)(ws + WS_W1A); N = 2 * FF; K = D; isw1 = true; }
        else if ((r -= I_W1) < I_W2) { W = a.in[8]; WT = (bf16*)(ws + WS_W2A); N = D; K = FF; }
        else if ((r -= I_W2) < I_IN) { W = a.in[9]; WT = (bf16*)(ws + WS_WIN); N = NIN; K = D; }
        else if ((r -= I_IN) < I_OUT) { W = a.in[13]; WT = (bf16*)(ws + WS_WOUT); N = D; K = D; }
        else if ((r -= I_OUT) < I_W1) { W = a.in[14]; WT = (bf16*)(ws + WS_W1B); N = 2 * FF; K = D; isw1 = true; }
        else { r -= I_W1; W = a.in[15]; WT = (bf16*)(ws + WS_W2B); N = D; K = FF; }
        const int nblk = N / 32, kb = r / nblk, nb = r - kb * nblk, n0 = 32 * nb;
        transpose_item(W, N, K, WT, 64 * kb, n0, isw1 ? w1_drow(n0) : n0, scr, lane);
    }
}

__device__ __forceinline__ void phase_normmod(const float* xl, const float* xc, int nrows, const float* g, const float* mod, int shift_slot, bf16* H) {
    const int tid = ltid(), lane = tid & 63, gw = lbid() * NWAVES + (tid >> 6), NGW = gridDim.x * NWAVES;
    for (int rb = gw; rb < nrows; rb += 4 * NGW) {
        f32x4 v[4][4]; float ss[4];
#pragma unroll
        for (int k = 0; k < 4; ++k) { const int row = rb + k * NGW; ss[k] = 0.f;
            if (row < nrows) { const float* xr = row < MX ? xl + (size_t)row * D : xc + (size_t)(row - MX) * D;
#pragma unroll
                for (int j = 0; j < 4; ++j) v[k][j] = *(const f32x4*)(xr + 4 * lane + 256 * j); } }
#pragma unroll
        for (int k = 0; k < 4; ++k) { const int row = rb + k * NGW;
            if (row < nrows) {
#pragma unroll
                for (int j = 0; j < 4; ++j) ss[k] += (v[k][j].x * v[k][j].x + v[k][j].y * v[k][j].y) + (v[k][j].z * v[k][j].z + v[k][j].w * v[k][j].w);
                ss[k] = wave_sum(ss[k]); } }
#pragma unroll
        for (int k = 0; k < 4; ++k) { const int row = rb + k * NGW;
            if (row < nrows) {
                const float rstd = 1.0f / sqrtf(ss[k] * (1.0f / D) + EPS);
                const float* mrow = mod + (row < MX ? (row >> 12) : 4) * NMODC + shift_slot * D;
#pragma unroll
                for (int j = 0; j < 4; ++j) {
                    const f32x4 gv = *(const f32x4*)(g + 4 * lane + 256 * j);
                    const f32x4 sh = *(const f32x4*)(mrow + 4 * lane + 256 * j), sc = *(const f32x4*)(mrow + D + 4 * lane + 256 * j);
                    const f32x4 y = (v[k][j] * rstd) * gv * (sc + 1.0f) + sh;
                    u32x2 o; o.x = pk2(y.x, y.y); o.y = pk2(y.z, y.w);
                    *(u32x2*)(H + (size_t)row * D + 4 * lane + 256 * j) = o; } } }
    }
}
__device__ __forceinline__ void phase_final(float* xo, const float* g) {
    const int tid = ltid(), lane = tid & 63, gw = lbid() * NWAVES + (tid >> 6), NGW = gridDim.x * NWAVES;
    for (int rb = gw; rb < MX; rb += 4 * NGW) {
        f32x4 v[4][4]; float ss[4];
#pragma unroll
        for (int k = 0; k < 4; ++k) { const int row = rb + k * NGW; ss[k] = 0.f;
            if (row < MX) {
#pragma unroll
                for (int j = 0; j < 4; ++j) v[k][j] = *(const f32x4*)(xo + (size_t)row * D + 4 * lane + 256 * j); } }
#pragma unroll
        for (int k = 0; k < 4; ++k) { const int row = rb + k * NGW;
            if (row < MX) {
#pragma unroll
                for (int j = 0; j < 4; ++j) ss[k] += (v[k][j].x * v[k][j].x + v[k][j].y * v[k][j].y) + (v[k][j].z * v[k][j].z + v[k][j].w * v[k][j].w);
                ss[k] = wave_sum(ss[k]); } }
#pragma unroll
        for (int k = 0; k < 4; ++k) { const int row = rb + k * NGW;
            if (row < MX) { const float rstd = 1.0f / sqrtf(ss[k] * (1.0f / D) + EPS);
#pragma unroll
                for (int j = 0; j < 4; ++j) { const f32x4 gv = *(const f32x4*)(g + 4 * lane + 256 * j); *(f32x4*)(xo + (size_t)row * D + 4 * lane + 256 * j) = (v[k][j] * rstd) * gv; } } }
    }
}

__device__ __forceinline__ void tile_load(const bf16* base, int pitch, int tp, int dg, float (&v)[2][2][8]) {
#pragma unroll
    for (int tk = 0; tk < 2; ++tk)
#pragma unroll
        for (int h = 0; h < 2; ++h) { const u32x4 r = *(const u32x4*)(base + (size_t)(2 * tp + tk) * pitch + 64 * h + 8 * dg);
            v[tk][h][0] = bf_lo(r.x); v[tk][h][1] = bf_hi(r.x); v[tk][h][2] = bf_lo(r.y); v[tk][h][3] = bf_hi(r.y);
            v[tk][h][4] = bf_lo(r.z); v[tk][h][5] = bf_hi(r.z); v[tk][h][6] = bf_lo(r.w); v[tk][h][7] = bf_hi(r.w); }
}
__device__ __forceinline__ void tile_rope(float (&v)[2][2][8], int pos0, int dg) {
#pragma unroll
    for (int tk = 0; tk < 2; ++tk) { const int n = pos0 + tk; const float p = (dg < 4) ? (float)(n >> 6) : (float)(n & 63);
#pragma unroll
        for (int i = 0; i < 8; ++i) { const int fi = 8 * (dg & 3) + i; const float fr = exp2f(-(float)fi * (13.287712379549449f / 32.0f)); const float ang = p * fr;
            float sn, cs; __sincosf(ang, &sn, &cs);
            const float t1 = v[tk][0][i], t2 = v[tk][1][i]; v[tk][0][i] = t1 * cs - t2 * sn; v[tk][1][i] = t1 * sn + t2 * cs; } }
}
__device__ __forceinline__ void tile_write_T(LAS bf16* T, int tp, int dg, const float (&v)[2][2][8], float w0, float w1) {
#pragma unroll
    for (int h = 0; h < 2; ++h)
#pragma unroll
        for (int i = 0; i < 8; ++i) { const int d = 64 * h + 8 * dg + i; const int c = (tp >> 2) ^ ((d >> 3) & 7);
            ((LAS unsigned*)T)[d * (TP / 2) + c * 4 + (tp & 3)] = pk2(v[0][h][i] * w0, v[1][h][i] * w1); }
}
__device__ __forceinline__ void tile_write_R(LAS bf16* T, int tp, int dg, const float (&v)[2][2][8]) {
#pragma unroll
    for (int tk = 0; tk < 2; ++tk)
#pragma unroll
        for (int h = 0; h < 2; ++h) { u32x4 o; o.x = pk2(v[tk][h][0], v[tk][h][1]); o.y = pk2(v[tk][h][2], v[tk][h][3]); o.z = pk2(v[tk][h][4], v[tk][h][5]); o.w = pk2(v[tk][h][6], v[tk][h][7]);
            *(LAS u32x4*)(T + (2 * tp + tk) * TP + 64 * h + 8 * dg) = o; }
}
__device__ __forceinline__ bf16x8 frag_R(const LAS bf16* T, int row, int ks, int q) { return *(const LAS bf16x8*)(T + row * TP + 32 * ks + 8 * q); }
__device__ __forceinline__ bf16x8 frag_T(const LAS bf16* T, int row, int ks, int q) { return *(const LAS bf16x8*)(T + row * TP + (((4 * ks + q) ^ ((row >> 3) & 7)) << 3)); }
template <bool SWZ>
__device__ __forceinline__ void strip_mma(f32x4 (&acc)[8], const bf16x8 (&xa)[4], const LAS bf16* Y, int r, int q) {
#pragma unroll
    for (int ks = 0; ks < 4; ++ks)
#pragma unroll
        for (int nt = 0; nt < 8; ++nt) { const bf16x8 yb = SWZ ? frag_T(Y, 16 * nt + r, ks, q) : frag_R(Y, 16 * nt + r, ks, q);
            acc[nt] = __builtin_amdgcn_mfma_f32_16x16x32_bf16(yb, xa[ks], acc[nt], 0, 0, 0); }
}

__device__ __forceinline__ void r1_state_item(const Args& a, LAS unsigned char* lds, int it) {
    const int tid = ltid(), lane = tid & 63, wave = tid >> 6, r = lane & 15, q = lane >> 4, tp = tid >> 3, dg = tid & 7;
    const bf16* P = (const bf16*)(a.ws + WS_ACT); bf16* U = (bf16*)(a.ws + WS_H);
    int h, row0, pos0; bool rope;
    if (it < 512) { const int bh = it >> 5, c = it & 31; h = bh & 3; row0 = (bh >> 2) * SEQ + c * CH; pos0 = c * CH; rope = true; }
    else { const int j = it - 512, bh = j >> 1, cc = j & 1; h = bh & 3; row0 = MX + (bh >> 2) * CTXL + cc * CH; pos0 = 0; rope = false; }
    const float lgf = -__expf(a.in[10][h]) * 1.4426950408889634f, lgb = -__expf(a.in[10][4 + h]) * 1.4426950408889634f;
    LAS bf16* Kt = (LAS bf16*)lds; LAS bf16* Vf = (LAS bf16*)(lds + TILE_B); LAS bf16* Vb = (LAS bf16*)(lds + 2 * TILE_B);
    {
        float v[2][2][8];
        tile_load(P + (size_t)row0 * NIN + 512 + h * 128, NIN, tp, dg, v);
        if (rope) tile_rope(v, pos0 + 2 * tp, dg);
        tile_write_T(Kt, tp, dg, v, 0.08838834764831845f, 0.08838834764831845f);
        tile_load(P + (size_t)row0 * NIN + 1024 + h * 128, NIN, tp, dg, v);
        const float t0 = (float)(2 * tp), t1 = t0 + 1.0f;
        tile_write_T(Vf, tp, dg, v, exp2f((127.0f - t0) * lgf), exp2f((127.0f - t1) * lgf));
        tile_write_T(Vb, tp, dg, v, exp2f(t0 * lgb), exp2f(t1 * lgb));
    }
    __syncthreads();
    bf16x8 xf[4], xb[4];
#pragma unroll
    for (int ks = 0; ks < 4; ++ks) { xf[ks] = frag_T(Vf, 16 * wave + r, ks, q); xb[ks] = frag_T(Vb, 16 * wave + r, ks, q); }
    f32x4 af[8], ab[8];
#pragma unroll
    for (int nt = 0; nt < 8; ++nt) { af[nt] = (f32x4){0.f, 0.f, 0.f, 0.f}; ab[nt] = (f32x4){0.f, 0.f, 0.f, 0.f}; }
    strip_mma<true>(af, xf, Kt, r, q);
    strip_mma<true>(ab, xb, Kt, r, q);
    bf16* uf = U + ((size_t)(it * 2 + 0) * 128 + 16 * wave + r) * 128 + 4 * q;
    bf16* ub = U + ((size_t)(it * 2 + 1) * 128 + 16 * wave + r) * 128 + 4 * q;
#pragma unroll
    for (int nt = 0; nt < 8; ++nt) {
        u32x2 o; o.x = pk2(af[nt][0], af[nt][1]); o.y = pk2(af[nt][2], af[nt][3]); *(u32x2*)(uf + 16 * nt) = o;
        o.x = pk2(ab[nt][0], ab[nt][1]); o.y = pk2(ab[nt][2], ab[nt][3]); *(u32x2*)(ub + 16 * nt) = o;
    }
    __syncthreads();
}
__device__ __forceinline__ void r1_gmlp_item(const Args& a, LAS unsigned char* lds, int j) {
    const int tid = ltid(), lane = tid & 63, wave = tid >> 6, r = lane & 15, q = lane >> 4, tp = tid >> 3, dg = tid & 7;
    const bf16* P = (const bf16*)(a.ws + WS_ACT); bf16* MIX = (bf16*)(a.ws + WS_MIX);
    const int g = j & 3, bc = j >> 2, row0 = bc * CH;
    LAS bf16* Wsb = (LAS bf16*)lds; LAS bf16* Vn = (LAS bf16*)(lds + TILE_B);
    const float* Ws = a.in[11] + (size_t)g * CH * CH;
#pragma unroll
    for (int i = 0; i < 8; ++i) { const int p = (tid >> 5) + 16 * i, c4 = 4 * (tid & 31); const f32x4 w = *(const f32x4*)(Ws + p * CH + c4);
        u32x2 o; o.x = pk2(w.x, w.y); o.y = pk2(w.z, w.w); *(LAS u32x2*)(Wsb + p * TP + c4) = o; }
    {
        float v[2][2][8];
        tile_load(P + (size_t)row0 * NIN + 2560 + g * 128, NIN, tp, dg, v);
#pragma unroll
        for (int tk = 0; tk < 2; ++tk) {
            float s = 0.f;
#pragma unroll
            for (int h = 0; h < 2; ++h)
#pragma unroll
                for (int i = 0; i < 8; ++i) { v[tk][h][i] = gelu_tanh(v[tk][h][i]); s += v[tk][h][i]; }
            s += __shfl_xor(s, 1); s += __shfl_xor(s, 2); s += __shfl_xor(s, 4);
            const float mu = s * (1.0f / 128.0f); float qv = 0.f;
#pragma unroll
            for (int h = 0; h < 2; ++h)
#pragma unroll
                for (int i = 0; i < 8; ++i) { v[tk][h][i] -= mu; qv += v[tk][h][i] * v[tk][h][i]; }
            qv += __shfl_xor(qv, 1); qv += __shfl_xor(qv, 2); qv += __shfl_xor(qv, 4);
            const float rs = 1.0f / sqrtf(qv * (1.0f / 128.0f) + EPS);
#pragma unroll
            for (int h = 0; h < 2; ++h)
#pragma unroll
                for (int i = 0; i < 8; ++i) v[tk][h][i] *= rs;
        }
        tile_write_T(Vn, tp, dg, v, 1.0f, 1.0f);
    }
    __syncthreads();
    bf16x8 xa[4];
#pragma unroll
    for (int ks = 0; ks < 4; ++ks) xa[ks] = frag_R(Wsb, 16 * wave + r, ks, q);
    f32x4 acc[8];
#pragma unroll
    for (int nt = 0; nt < 8; ++nt) acc[nt] = (f32x4){0.f, 0.f, 0.f, 0.f};
    strip_mma<true>(acc, xa, Vn, r, q);
    const int p = 16 * wave + r; const float bs = a.in[12][g * CH + p];
    const bf16* up = P + (size_t)(row0 + p) * NIN + 2048 + g * 128 + 4 * q;
    bf16* op = MIX + (size_t)(row0 + p) * D + 512 + g * 128 + 4 * q;
#pragma unroll
    for (int nt = 0; nt < 8; ++nt) { const u32x2 uu = *(const u32x2*)(up + 16 * nt);
        const float o0 = gelu_tanh(bf_lo(uu.x)) * (acc[nt][0] + bs), o1 = gelu_tanh(bf_hi(uu.x)) * (acc[nt][1] + bs), o2 = gelu_tanh(bf_lo(uu.y)) * (acc[nt][2] + bs), o3 = gelu_tanh(bf_hi(uu.y)) * (acc[nt][3] + bs);
        u32x2 o; o.x = pk2(o0, o1); o.y = pk2(o2, o3); *(u32x2*)(op + 16 * nt) = o; }
    __syncthreads();
}
__device__ __forceinline__ void phase_r1(const Args& a, LAS unsigned char* lds) {
    for (int it = lbid(); it < 544 + 512; it += gridDim.x) { if (it < 544) r1_state_item(a, lds, it); else r1_gmlp_item(a, lds, it - 544); }
}
__device__ __forceinline__ void phase_r2(const Args& a) {
    bf16* U = (bf16*)(a.ws + WS_H);
    for (int gidx = lbid() * NTHR + ltid(); gidx < 16 * 2 * 4096; gidx += gridDim.x * NTHR) {
        const int bh = gidx >> 13, dir = (gidx >> 12) & 1, e4 = gidx & 4095, h = bh & 3;
        const float dec = __expf(-__expf(a.in[10][dir * 4 + h]) * 128.0f);
        const size_t eo = (size_t)dir * 16384 + 4 * e4;
        const u32x2 c0 = *(const u32x2*)(U + (size_t)(512 + bh * 2 + 0) * 32768 + eo), c1 = *(const u32x2*)(U + (size_t)(512 + bh * 2 + 1) * 32768 + eo);
        float s0, s1, s2, s3;
        if (dir == 0) { s0 = dec * bf_lo(c0.x) + bf_lo(c1.x); s1 = dec * bf_hi(c0.x) + bf_hi(c1.x); s2 = dec * bf_lo(c0.y) + bf_lo(c1.y); s3 = dec * bf_hi(c0.y) + bf_hi(c1.y); }
        else          { s0 = dec * bf_lo(c1.x) + bf_lo(c0.x); s1 = dec * bf_hi(c1.x) + bf_hi(c0.x); s2 = dec * bf_lo(c1.y) + bf_lo(c0.y); s3 = dec * bf_hi(c1.y) + bf_hi(c0.y); }
#pragma unroll 8
        for (int k = 0; k < NCH; ++k) { const int c = dir == 0 ? k : NCH - 1 - k;
            u32x2* p = (u32x2*)(U + (size_t)(bh * 32 + c) * 32768 + eo); const u32x2 t = *p;
            u32x2 o; o.x = pk2(s0, s1); o.y = pk2(s2, s3); *p = o;
            s0 = dec * s0 + bf_lo(t.x); s1 = dec * s1 + bf_hi(t.x); s2 = dec * s2 + bf_lo(t.y); s3 = dec * s3 + bf_hi(t.y); }
    }
}
__device__ __forceinline__ void r3_item(const Args& a, LAS unsigned char* lds, int it) {
    const int tid = ltid(), lane = tid & 63, wave = tid >> 6, r = lane & 15, q = lane >> 4, tp = tid >> 3, dg = tid & 7;
    const bf16* P = (const bf16*)(a.ws + WS_ACT); const bf16* S = (const bf16*)(a.ws + WS_H); bf16* MIX = (bf16*)(a.ws + WS_MIX);
    const int bh = it >> 5, c = it & 31, h = bh & 3, row0 = (bh >> 2) * SEQ + c * CH, pos0 = c * CH;
    const float lgf = -__expf(a.in[10][h]) * 1.4426950408889634f, lgb = -__expf(a.in[10][4 + h]) * 1.4426950408889634f;
    LAS bf16* Ks = (LAS bf16*)lds; LAS bf16* Vt = (LAS bf16*)(lds + TILE_B); LAS bf16* Sf = (LAS bf16*)(lds + 2 * TILE_B); LAS bf16* Sb = (LAS bf16*)(lds + 3 * TILE_B);
    {
        float v[2][2][8];
        tile_load(P + (size_t)row0 * NIN + 512 + h * 128, NIN, tp, dg, v);
        tile_rope(v, pos0 + 2 * tp, dg);
#pragma unroll
        for (int tk = 0; tk < 2; ++tk)
#pragma unroll
            for (int hh = 0; hh < 2; ++hh)
#pragma unroll
                for (int i = 0; i < 8; ++i) v[tk][hh][i] *= 0.08838834764831845f;
        tile_write_R(Ks, tp, dg, v);
        tile_load(P + (size_t)row0 * NIN + 1024 + h * 128, NIN, tp, dg, v);
        tile_write_T(Vt, tp, dg, v, 1.0f, 1.0f);
        const bf16* sf = S + (size_t)(it * 2 + 0) * 16384; const bf16* sb = S + (size_t)(it * 2 + 1) * 16384;
#pragma unroll
        for (int i = 0; i < 4; ++i) { const int id = tid + NTHR * i, rr = id >> 4, c8 = id & 15;
            *(LAS u32x4*)(Sf + rr * TP + 8 * c8) = *(const u32x4*)(sf + rr * 128 + 8 * c8);
            *(LAS u32x4*)(Sb + rr * TP + 8 * c8) = *(const u32x4*)(sb + rr * 128 + 8 * c8); }
    }
    const int irow = 16 * wave + r;
    bf16x8 xq[4];
    {
        const bf16* qp = P + (size_t)(row0 + irow) * NIN + h * 128 + 8 * q;
        float f[4][8];
#pragma unroll
        for (int ks = 0; ks < 4; ++ks) { const u32x4 rw = *(const u32x4*)(qp + 32 * ks);
            f[ks][0] = bf_lo(rw.x); f[ks][1] = bf_hi(rw.x); f[ks][2] = bf_lo(rw.y); f[ks][3] = bf_hi(rw.y); f[ks][4] = bf_lo(rw.z); f[ks][5] = bf_hi(rw.z); f[ks][6] = bf_lo(rw.w); f[ks][7] = bf_hi(rw.w); }
        const int n = pos0 + irow;
#pragma unroll
        for (int ks = 0; ks < 2; ++ks) { const float p = ks == 0 ? (float)(n >> 6) : (float)(n & 63);
#pragma unroll
            for (int i = 0; i < 8; ++i) { const int fi = 8 * q + i; const float fr = exp2f(-(float)fi * (13.287712379549449f / 32.0f)); float sn, cs; __sincosf(p * fr, &sn, &cs);
                const float t1 = f[ks][i], t2 = f[ks + 2][i]; f[ks][i] = t1 * cs - t2 * sn; f[ks + 2][i] = t1 * sn + t2 * cs; } }
#pragma unroll
        for (int ks = 0; ks < 4; ++ks) { u32x4 o; o.x = pk2(f[ks][0], f[ks][1]); o.y = pk2(f[ks][2], f[ks][3]); o.z = pk2(f[ks][4], f[ks][5]); o.w = pk2(f[ks][6], f[ks][7]); xq[ks] = __builtin_bit_cast(bf16x8, o); }
    }
    __syncthreads();
    f32x4 acc[8];
#pragma unroll
    for (int nt = 0; nt < 8; ++nt) acc[nt] = (f32x4){0.f, 0.f, 0.f, 0.f};
    strip_mma<false>(acc, xq, Ks, r, q);
    __syncthreads();
    LAS bf16* Ps = Ks;
#pragma unroll
    for (int nt = 0; nt < 8; ++nt) { float pv[4];
#pragma unroll
        for (int jj = 0; jj < 4; ++jj) { const int df = irow - (16 * nt + 4 * q + jj);
            const float m = df > 0 ? exp2f((float)df * lgf) : (df < 0 ? exp2f((float)(-df) * lgb) : 2.0f); pv[jj] = acc[nt][jj] * m; }
        u32x2 o; o.x = pk2(pv[0], pv[1]); o.y = pk2(pv[2], pv[3]); *(LAS u32x2*)(Ps + irow * TP + 16 * nt + 4 * q) = o; }
    const float xif = exp2f((float)(irow + 1) * lgf), xib = exp2f((float)(128 - irow) * lgb);
#pragma unroll
    for (int nt = 0; nt < 8; ++nt) acc[nt] = (f32x4){0.f, 0.f, 0.f, 0.f};
    strip_mma<false>(acc, xq, Sb, r, q);
    { const float rt = xib / xif;
#pragma unroll
      for (int nt = 0; nt < 8; ++nt) acc[nt] *= rt; }
    strip_mma<false>(acc, xq, Sf, r, q);
#pragma unroll
    for (int nt = 0; nt < 8; ++nt) acc[nt] *= xif;
    {
        bf16x8 xp[4];
#pragma unroll
        for (int ks = 0; ks < 4; ++ks) xp[ks] = frag_R(Ps, irow, ks, q);
        strip_mma<true>(acc, xp, Vt, r, q);
    }
    float ss = 0.f;
#pragma unroll
    for (int nt = 0; nt < 8; ++nt) ss += (acc[nt][0] * acc[nt][0] + acc[nt][1] * acc[nt][1]) + (acc[nt][2] * acc[nt][2] + acc[nt][3] * acc[nt][3]);
    ss += __shfl_xor(ss, 16); ss += __shfl_xor(ss, 32);
    const float rstd = 1.0f / sqrtf(ss * (1.0f / 128.0f) + EPS);
    const bf16* gp = P + (size_t)(row0 + irow) * NIN + 1536 + h * 128 + 4 * q;
    bf16* op = MIX + (size_t)(row0 + irow) * D + h * 128 + 4 * q;
#pragma unroll
    for (int nt = 0; nt < 8; ++nt) { const u32x2 gg = *(const u32x2*)(gp + 16 * nt);
        u32x2 o; o.x = pk2(acc[nt][0] * rstd * pg8::silu_f(bf_lo(gg.x)), acc[nt][1] * rstd * pg8::silu_f(bf_hi(gg.x)));
        o.y = pk2(acc[nt][2] * rstd * pg8::silu_f(bf_lo(gg.y)), acc[nt][3] * rstd * pg8::silu_f(bf_hi(gg.y)));
        *(u32x2*)(op + 16 * nt) = o; }
    __syncthreads();
}

template <int MODE>
__device__ __forceinline__ void ctx_gemm(const Args& a, LAS unsigned char* lds, const bf16* A, const bf16* Bt, int K) {
    constexpr int PT = 264, BUFB = 2 * 64 * PT * 2;
    const int tid = ltid(), lane = tid & 63, wave = tid >> 6, r = lane & 15, q = lane >> 4;
    const int nk = K >> 8;
    for (int t = lbid(); t < 256; t += gridDim.x) {
        const int tm = t >> 4, tn = t & 15;
        const bf16* Ag = A + (size_t)(64 * tm) * K; const bf16* Bg = Bt + (size_t)(64 * tn) * K;
        u32x4 ra[4], rb[4];
#define CG_LOAD(kc) do { _Pragma("unroll") for (int i = 0; i < 4; ++i) { const int id = tid + NTHR * i, row = id >> 5, c8 = id & 31; \
            ra[i] = *(const u32x4*)(Ag + (size_t)row * K + (kc) * 256 + 8 * c8); rb[i] = *(const u32x4*)(Bg + (size_t)row * K + (kc) * 256 + 8 * c8); } } while (0)
#define CG_STORE(b) do { LAS bf16* As_ = (LAS bf16*)(lds + (b) * BUFB); _Pragma("unroll") for (int i = 0; i < 4; ++i) { const int id = tid + NTHR * i, row = id >> 5, c8 = id & 31; \
            *(LAS u32x4*)(As_ + row * PT + 8 * c8) = ra[i]; *(LAS u32x4*)(As_ + (64 + row) * PT + 8 * c8) = rb[i]; } } while (0)
        f32x4 acc[2] = {(f32x4){0.f, 0.f, 0.f, 0.f}, (f32x4){0.f, 0.f, 0.f, 0.f}};
        CG_LOAD(0); CG_STORE(0); __syncthreads();
        for (int kc = 0; kc < nk; ++kc) {
            if (kc + 1 < nk) CG_LOAD(kc + 1);
            const LAS bf16* As = (const LAS bf16*)(lds + (kc & 1) * BUFB); const LAS bf16* Bs = As + 64 * PT;
#pragma unroll
            for (int ks = 0; ks < 8; ++ks) { const bf16x8 xa = *(const LAS bf16x8*)(As + (16 * (wave & 3) + r) * PT + 32 * ks + 8 * q);
#pragma unroll
                for (int nt = 0; nt < 2; ++nt) { const bf16x8 yb = *(const LAS bf16x8*)(Bs + (32 * (wave >> 2) + 16 * nt + r) * PT + 32 * ks + 8 * q);
                    acc[nt] = __builtin_amdgcn_mfma_f32_16x16x32_bf16(yb, xa, acc[nt], 0, 0, 0); } }
            if (kc + 1 < nk) CG_STORE((kc + 1) & 1);
            __syncthreads();
        }
#undef CG_LOAD
#undef CG_STORE
        const int row = 64 * tm + 16 * (wave & 3) + r;
#pragma unroll
        for (int nt = 0; nt < 2; ++nt) { const int col = 64 * tn + 32 * (wave >> 2) + 16 * nt + 4 * q;
            if (MODE == 0) { const f32x4 xi = *(const f32x4*)(a.in[2] + (size_t)row * D + col); const f32x4 gt = *(const f32x4*)((const float*)(a.ws + WS_MOD) + 4 * NMODC + 2 * D + col);
                *(f32x4*)((float*)(a.ws + WS_X1C) + (size_t)row * D + col) = xi + gt * 0.5f * acc[nt]; }
            else { u32x2 o; o.x = pk2(acc[nt][0], acc[nt][1]); o.y = pk2(acc[nt][2], acc[nt][3]);
                *(u32x2*)((bf16*)(a.ws + WS_ACT) + (size_t)(MX + row) * NIN + 512 + col) = o; } }
    }
}

#ifndef ONLY
#define ONLY (-1)
#endif
#define ON(p) (ONLY < 0 || ONLY == (p))
enum { PH_P0 = 0, PH_P1, PH_G1, PH_G2, PH_P2, PH_G3, PH_R1, PH_R2, PH_R3, PH_G4, PH_P3, PH_G5, PH_G6, PH_F, PH_N };

__global__ void __launch_bounds__(NTHR, 2) mk_fwd(Args a) {
    extern __shared__ __attribute__((aligned(16))) unsigned char lds_raw[];
    LAS unsigned char* lds = (LAS unsigned char*)lds_raw;
    cg::grid_group grid = cg::this_grid();
    volatile LAS unsigned* xbst = (volatile LAS unsigned*)(lds + LDS_BYTES - 16);
    if (threadIdx.x < 4) xbst[threadIdx.x] = 0u;
    __syncthreads();
    XcdBarrier xbar = xcd_barrier_post((unsigned*)(a.ws + WS_BAR), xbst);
    unsigned char* ws = a.ws;
    const float* mod = (const float*)(ws + WS_MOD);
    bf16* H = (bf16*)(ws + WS_H); bf16* ACT = (bf16*)(ws + WS_ACT); bf16* MIX = (bf16*)(ws + WS_MIX);
    float* X1C = (float*)(ws + WS_X1C);
    const int G = gridDim.x;
#ifdef LEAK_MASK
    unsigned long long leak = 0ull;
#endif
    for (int ph = a.ph_lo; ph < a.ph_hi; ++ph) {
        const int bx = lbid();
#ifdef LEAK_MASK
        const unsigned long long lk0 = __builtin_amdgcn_s_memrealtime();
#endif
        switch (ph) {
        case PH_P0: if constexpr (ON(PH_P0)) phase_p0(a, lds); break;
        case PH_P1: if constexpr (ON(PH_P1)) phase_normmod(a.in[0], a.in[2], MT, a.in[6], mod, 0, H); break;
        case PH_P2: if constexpr (ON(PH_P1)) phase_normmod(a.out, X1C, MT, a.in[6] + D, mod, 3, H); break;
        case PH_P3: if constexpr (ON(PH_P1)) phase_normmod(a.out, X1C, MX, a.in[6] + 2 * D, mod, 6, H); break;
        case PH_G1: case PH_G5: if constexpr (ON(PH_G1)) {
            const int M = ph == PH_G1 ? MT : MX;
            pg8::Gemm g{H, (const bf16*)(ws + (ph == PH_G1 ? WS_W1A : WS_W1B)), M, 2 * FF, D}; pg8::StaticOrder S; S.init(M, 2 * FF, G, bx);
            pg8::EpiSwiglu E{ACT, FF};
            pg8::gemm_phase<pg8::EpiSwiglu, pg8::StaticOrder, true, true>(lds, g, S, E);
        } break;
        case PH_G2: case PH_G4: case PH_G6: if constexpr (ON(PH_G2)) {
            pg8::Gemm g; pg8::EpiResid E;
            if (ph == PH_G2)      { g = pg8::Gemm{ACT, (const bf16*)(ws + WS_W2A), MX, D, FF}; E = pg8::EpiResid{a.in[0], a.in[2], a.out, X1C, mod, 2, 0.5f}; }
            else if (ph == PH_G4) { g = pg8::Gemm{MIX, (const bf16*)(ws + WS_WOUT), MX, D, D}; E = pg8::EpiResid{a.out, X1C, a.out, X1C, mod, 5, 1.0f}; }
            else                  { g = pg8::Gemm{ACT, (const bf16*)(ws + WS_W2B), MX, D, FF}; E = pg8::EpiResid{a.out, X1C, a.out, X1C, mod, 8, 0.5f}; }
            pg8::StaticOrder S; S.init(g.M, g.N, G, bx);
            pg8::gemm_phase<pg8::EpiResid, pg8::StaticOrder, true, true>(lds, g, S, E);
            if (ph == PH_G2) ctx_gemm<0>(a, lds, ACT + (size_t)MX * FF, (const bf16*)(ws + WS_W2A), FF);
        } break;
        case PH_G3: if constexpr (ON(PH_G3)) {
            pg8::Gemm g{H, (const bf16*)(ws + WS_WIN), MX, NIN, D}; pg8::StaticOrder S; S.init(MX, NIN, G, bx);
            pg8::EpiPlainBf16 E{ACT, NIN};
            pg8::gemm_phase<pg8::EpiPlainBf16, pg8::StaticOrder, true, true>(lds, g, S, E);
            ctx_gemm<1>(a, lds, H + (size_t)MX * D, (const bf16*)(ws + WS_WIN) + (size_t)512 * D, D);
        } break;
        case PH_R1: if constexpr (ON(PH_R1)) phase_r1(a, lds); break;
        case PH_R2: if constexpr (ON(PH_R2)) phase_r2(a); break;
        case PH_R3: if constexpr (ON(PH_R3)) for (int it = bx; it < 512; it += G) r3_item(a, lds, it); break;
        case PH_F: if constexpr (ON(PH_F)) phase_final(a.out, a.in[16]); break;
        default: break;
        }
        if (ph + 1 < a.ph_hi) {
            if (a.ph_hi > PH_N) grid.sync();
            xcd_barrier(xbar);
        }
#ifdef LEAK_MASK
        if ((LEAK_MASK >> ph) & 1) leak += __builtin_amdgcn_s_memrealtime() - lk0;
#endif
    }
#ifdef LEAK_MASK
    if (blockIdx.x == 0) { const unsigned long long t0 = __builtin_amdgcn_s_memrealtime(); while (__builtin_amdgcn_s_memrealtime() - t0 < leak) __builtin_amdgcn_s_sleep(8); }
#endif
}

extern "C" void kernel_launch(void* const* d_in, const int* in_sizes, int n_in, void* d_out, int out_size, void* d_ws, size_t ws_size, hipStream_t stream) {
    static int grid = 0;
    if (grid == 0) {
        if (n_in != 17 || out_size != MX * D || ws_size < WS_END) { fprintf(stderr, "kernel_launch: unexpected shapes (n_in %d out %d ws %zu)\n", n_in, out_size, ws_size); grid = -1; return; }
        int dev = 0, cus = 0, per_cu = 0;
        hipGetDevice(&dev); hipDeviceGetAttribute(&cus, hipDeviceAttributeMultiprocessorCount, dev);
        if (hipFuncSetAttribute((const void*)mk_fwd, hipFuncAttributeMaxDynamicSharedMemorySize, LDS_BYTES) != hipSuccess) { fprintf(stderr, "kernel_launch: hipFuncSetAttribute failed\n"); grid = -1; return; }
        if (hipOccupancyMaxActiveBlocksPerMultiprocessor(&per_cu, (const void*)mk_fwd, NTHR, LDS_BYTES) != hipSuccess || per_cu < 1) { fprintf(stderr, "kernel_launch: occupancy query failed (%d)\n", per_cu); (void)hipGetLastError(); per_cu = 1; }
        grid = cus * per_cu;
        fprintf(stderr, "kernel_launch: %d CUs x %d = grid %d\n", cus, per_cu, grid);
    }
    if (grid < 0) return;
    if (hipMemsetAsync((char*)d_ws + WS_BAR, 0, XCD_BAR_WORDS * 4, stream) != hipSuccess) { fprintf(stderr, "kernel_launch: memset failed\n"); return; }
    Args a{};
    for (int i = 0; i < 17; ++i) a.in[i] = (const float*)d_in[i];
    a.out = (float*)d_out; a.ws = (unsigned char*)d_ws; a.ph_lo = 0; a.ph_hi = PH_N;
#ifndef N_LAUNCH_PER_PHASE
    void* args[] = {&a};
    const hipError_t e = hipLaunchCooperativeKernel((const void*)mk_fwd, dim3(grid), dim3(NTHR), args, LDS_BYTES, stream);
    if (e != hipSuccess) fprintf(stderr, "kernel_launch: cooperative launch failed: %s (grid %d)\n", hipGetErrorString(e), grid);
#else
    for (int p = 0; p < PH_N; ++p) { if (!((PHASE_MASK >> p) & 1)) continue; a.ph_lo = p; a.ph_hi = p + 1; hipLaunchKernelGGL(mk_fwd, dim3(grid), dim3(NTHR), LDS_BYTES, stream, a); }
#endif
}
```
